# Optimizing an MI355X kernel written in HIP

```python
import jax, jax.numpy as jnp
from jax import lax
import numpy as np

D_MODEL = 2048
BATCH = 2
SEQ = 8192
DEPTH = 1

CHUNK = 64
MEM_LEN = 256
D_MIX = D_MODEL
D_POOL = D_MIX // 2
POOL_WINDOWS = (2, 4, 8, 16)
N_POOL_GROUPS = len(POOL_WINDOWS)
POOL_GROUP = D_POOL // N_POOL_GROUPS
D_GLA = D_MIX - D_POOL
GLA_HEADS = 4
GLA_DV = D_GLA // GLA_HEADS
GLA_DK = GLA_DV // 2
D_GLA_K = GLA_HEADS * GLA_DK
GLA_GATE_RANK = 16
GLA_GATE_TEMP = 16.0
XATTN_HEADS = 4
XATTN_HEAD_DIM = D_MODEL // XATTN_HEADS
D_FF = ((8 * D_MODEL // 3 + 255) // 256) * 256
RMS_EPS = 1e-6
IN_SPLITS = (D_POOL,
             D_POOL + D_GLA_K,
             D_POOL + 2 * D_GLA_K,
             D_POOL + 2 * D_GLA_K + D_GLA,
             D_POOL + 2 * D_GLA_K + 2 * D_GLA)
IN_COLS = D_POOL + 2 * D_GLA_K + 2 * D_GLA + GLA_GATE_RANK

kernel_name = "hymba_pool_gla_macaron_memxattn"


def rms_norm(x, gain):
    xf = x.astype(jnp.float32)
    y = xf * lax.rsqrt(jnp.mean(xf * xf, axis=-1, keepdims=True) + RMS_EPS)
    return (y * gain.astype(jnp.float32)).astype(x.dtype)


def swiglu(h, w_gate, w_up, w_down):
    return (jax.nn.silu(h @ w_gate) * (h @ w_up)) @ w_down


def pool_mixer(u, pool_w, pool_scale):
    b, s, _ = u.shape
    uf = u.astype(jnp.float32).reshape(b, s, N_POOL_GROUPS, POOL_GROUP)
    cs = jnp.cumsum(uf, axis=1)
    count = jnp.arange(1, s + 1, dtype=jnp.float32)
    diffs = []
    for g, w in enumerate(POOL_WINDOWS):
        cs_g = cs[:, :, g]
        lagged = jnp.pad(cs_g, ((0, 0), (w, 0), (0, 0)))[:, :s]
        mean = (cs_g - lagged) / jnp.minimum(count, float(w))[None, :, None]
        diffs.append(mean - uf[:, :, g])
    d = jnp.stack(diffs, axis=2).astype(u.dtype)
    y = jnp.einsum('bsgc,gcd->bsgd', d, pool_w)
    return y.reshape(b, s, D_POOL) * pool_scale


def gla_mixer(q, k, v, g, a_lr, w_a2, b_a, head_norm):
    b, s, _ = q.shape
    nc = s // CHUNK
    dt = v.dtype
    log_a = jax.nn.log_sigmoid((a_lr @ w_a2 + b_a).astype(jnp.float32)) / GLA_GATE_TEMP

    def chunks(t, d):
        return t.astype(jnp.float32).reshape(b, nc, CHUNK, GLA_HEADS, d)

    qc = chunks(q, GLA_DK) * (GLA_DK ** -0.5)
    kc = chunks(k, GLA_DK)
    vc = chunks(v, GLA_DV)
    cum = jnp.cumsum(chunks(log_a, GLA_DK), axis=2)
    b_end = cum[:, :, -1:]
    k_dec = kc * jnp.exp(b_end - cum)
    q_dec = qc * jnp.exp(b_end)
    scores = jnp.einsum('bnihk,bnjhk->bnhij', qc, k_dec)
    o_intra = jnp.einsum('bnhij,bnjhv->bnihv', scores, vc)

    def step(state, xs):
        q_c, k_c, v_c, decay_c = xs
        o = jnp.einsum('bihk,bhkv->bihv', q_c, state)
        state = decay_c[..., None] * state + jnp.einsum('bjhk,bjhv->bhkv', k_c, v_c)
        return state, o

    xs = (jnp.moveaxis(q_dec, 1, 0), jnp.moveaxis(k_dec, 1, 0),
          jnp.moveaxis(vc, 1, 0), jnp.moveaxis(jnp.exp(b_end[:, :, 0]), 1, 0))
    s0 = jnp.zeros((b, GLA_HEADS, GLA_DK, GLA_DV), jnp.float32)
    _, o_inter = lax.scan(step, s0, xs)
    o = o_intra + jnp.moveaxis(o_inter, 0, 1)
    o = o * lax.rsqrt(jnp.mean(o * o, axis=-1, keepdims=True) + RMS_EPS)
    o = o.reshape(b, s, D_GLA) * head_norm.astype(jnp.float32)
    return o.astype(dt) * jax.nn.silu(g)


def mem_cross_attention(h, mem_h, w_q, w_kv, w_o):
    b, s, _ = h.shape
    q = (h @ w_q).reshape(b, s, XATTN_HEADS, XATTN_HEAD_DIM)
    kv = (mem_h @ w_kv).reshape(b, mem_h.shape[1], 2, XATTN_HEADS, XATTN_HEAD_DIM)
    k, v = kv[:, :, 0], kv[:, :, 1]
    logits = jnp.einsum('bshd,bmhd->bhsm', q, k).astype(jnp.float32) * (XATTN_HEAD_DIM ** -0.5)
    p = jax.nn.softmax(logits, axis=-1).astype(v.dtype)
    o = jnp.einsum('bhsm,bmhd->bshd', p, v).reshape(b, s, D_MODEL)
    return o @ w_o


def setup_inputs(seed: int = 0) -> dict:
    key = jax.random.key(seed)
    ks = jax.random.split(key, 32)

    def dense(k, shape, fan_in):
        return jax.random.normal(k, shape, jnp.float32) * (fan_in ** -0.5)

    def gain(k, shape):
        return 1.0 + 0.02 * jax.random.normal(k, shape, jnp.float32)

    L = DEPTH
    return {
        "x": jax.random.normal(ks[0], (BATCH, SEQ, D_MODEL), jnp.float32),
        "mem": jax.random.normal(ks[1], (BATCH, MEM_LEN, D_MODEL), jnp.float32),
        "ffn1_norm": gain(ks[2], (L, D_MODEL)),
        "ffn1_w_gate": dense(ks[3], (L, D_MODEL, D_FF), D_MODEL),
        "ffn1_w_up": dense(ks[4], (L, D_MODEL, D_FF), D_MODEL),
        "ffn1_w_down": dense(ks[5], (L, D_FF, D_MODEL), D_FF),
        "mix_norm": gain(ks[6], (L, D_MODEL)),
        "w_in": dense(ks[7], (L, D_MODEL, IN_COLS), D_MODEL),
        "pool_w": dense(ks[8], (L, N_POOL_GROUPS, POOL_GROUP, POOL_GROUP), POOL_GROUP),
        "pool_scale": 1.0 + 0.1 * jax.random.normal(ks[9], (L, D_POOL), jnp.float32),
        "gla_w_a2": dense(ks[10], (L, GLA_GATE_RANK, D_GLA_K), GLA_GATE_RANK),
        "gla_b_a": 0.1 * jax.random.normal(ks[11], (L, D_GLA_K), jnp.float32),
        "gla_head_norm": gain(ks[12], (L, D_GLA)),
        "w_out": dense(ks[13], (L, D_MIX, D_MODEL), D_MIX),
        "xattn_norm": gain(ks[14], (L, D_MODEL)),
        "mem_norm": gain(ks[15], (L, D_MODEL)),
        "xattn_w_q": dense(ks[16], (L, D_MODEL, D_MODEL), D_MODEL),
        "xattn_w_kv": dense(ks[17], (L, D_MODEL, 2 * D_MODEL), D_MODEL),
        "xattn_w_o": dense(ks[18], (L, D_MODEL, D_MODEL), D_MODEL),
        "ffn2_norm": gain(ks[19], (L, D_MODEL)),
        "ffn2_w_gate": dense(ks[20], (L, D_MODEL, D_FF), D_MODEL),
        "ffn2_w_up": dense(ks[21], (L, D_MODEL, D_FF), D_MODEL),
        "ffn2_w_down": dense(ks[22], (L, D_FF, D_MODEL), D_FF),
        "final_norm": gain(ks[23], (D_MODEL,)),
    }


def reference(x, mem, ffn1_norm, ffn1_w_gate, ffn1_w_up, ffn1_w_down, mix_norm, w_in,
              pool_w, pool_scale, gla_w_a2, gla_b_a, gla_head_norm, w_out,
              xattn_norm, mem_norm, xattn_w_q, xattn_w_kv, xattn_w_o,
              ffn2_norm, ffn2_w_gate, ffn2_w_up, ffn2_w_down, final_norm):
    for l in range(DEPTH):
        x = x + 0.5 * swiglu(rms_norm(x, ffn1_norm[l]), ffn1_w_gate[l], ffn1_w_up[l], ffn1_w_down[l])
        h = rms_norm(x, mix_norm[l])
        proj = h @ w_in[l]
        u, q, k, v, g, a_lr = jnp.split(proj, list(IN_SPLITS), axis=-1)
        y_pool = pool_mixer(u, pool_w[l], pool_scale[l])
        y_gla = gla_mixer(q, k, v, g, a_lr, gla_w_a2[l], gla_b_a[l], gla_head_norm[l])
        x = x + jnp.concatenate([y_pool, y_gla], axis=-1) @ w_out[l]
        x = x + mem_cross_attention(rms_norm(x, xattn_norm[l]), rms_norm(mem, mem_norm[l]),
                                    xattn_w_q[l], xattn_w_kv[l], xattn_w_o[l])
        x = x + 0.5 * swiglu(rms_norm(x, ffn2_norm[l]), ffn2_w_gate[l], ffn2_w_up[l], ffn2_w_down[l])
    return rms_norm(x, final_norm)
```

```cpp
#include <hip/hip_runtime.h>
#include <hip/hip_cooperative_groups.h>
#include <cstdio>
#include <cstdint>
namespace cg = cooperative_groups;

#define LAS __attribute__((address_space(3)))
typedef unsigned short bf16_t;
typedef short bf16x8 __attribute__((ext_vector_type(8)));
typedef float f32x4 __attribute__((ext_vector_type(4)));
typedef float f32x2 __attribute__((ext_vector_type(2)));
typedef unsigned u32x4 __attribute__((ext_vector_type(4)));
typedef unsigned u32x2 __attribute__((ext_vector_type(2)));

constexpr int T = 16384, D = 2048, FF = 5632, SEQ = 8192, MEMT = 512;
constexpr int NWG = 256, NTHR = 512;
constexpr float EPS = 1e-6f;

constexpr size_t WS_BAR   = 0;
constexpr size_t WS_SS    = 16384;
constexpr size_t WS_ALR   = WS_SS + 4ull * T * 32 * 4;
constexpr size_t WS_BEND  = WS_ALR + (size_t)T * 16 * 4;
constexpr size_t WS_MEMH  = WS_BEND + 1024ull * 128 * 4;
constexpr size_t WS_MEMK  = WS_MEMH + (size_t)MEMT * D * 2;
constexpr size_t WS_MEMVT = WS_MEMK + (size_t)MEMT * D * 2;
constexpr size_t WS_W1GU  = WS_MEMVT + (size_t)MEMT * D * 2;
constexpr size_t WS_W1D   = WS_W1GU + 2ull * FF * D * 2;
constexpr size_t WS_W2GU  = WS_W1D + (size_t)FF * D * 2;
constexpr size_t WS_W2D   = WS_W2GU + 2ull * FF * D * 2;
constexpr size_t WS_WIN   = WS_W2D + (size_t)FF * D * 2;
constexpr size_t WS_WA    = WS_WIN + 4096ull * D * 2;
constexpr size_t WS_POOLW = WS_WA + 16ull * D * 2;
constexpr size_t WS_WOUT  = WS_POOLW + 4ull * 256 * 256 * 2;
constexpr size_t WS_WQ    = WS_WOUT + (size_t)D * D * 2;
constexpr size_t WS_WKV   = WS_WQ + (size_t)D * D * 2;
constexpr size_t WS_WO    = WS_WKV + 2ull * D * D * 2;
constexpr size_t WS_H     = WS_WO + (size_t)D * D * 2;
constexpr size_t WS_ACT   = WS_H + (size_t)T * D * 2;
constexpr size_t WS_MIX   = WS_ACT + (size_t)T * FF * 2;
constexpr size_t WS_END   = WS_MIX + (size_t)T * D * 2;
constexpr size_t ACT_KT   = (size_t)T * 4096 * 2;
constexpr size_t ACT_VT   = ACT_KT + 1024ull * 8192 * 2;
constexpr size_t ACT_PATT = (size_t)T * D * 2;
constexpr size_t ACT_WQK  = ACT_KT;
constexpr size_t ACT_VWOT = ACT_WQK + 2ull * 1024 * D * 2;

constexpr int LDS_BYTES = 139264;

typedef __bf16 bf16x2_t __attribute__((ext_vector_type(2)));
__device__ __forceinline__ unsigned cvt_pk_bf16(float lo, float hi) { const f32x2 v = {lo, hi}; const bf16x2_t r = __builtin_convertvector(v, bf16x2_t); return __builtin_bit_cast(unsigned, r); }
__device__ __forceinline__ u32x4 pair16(u32x2 a, u32x2 b) {
    const auto rx = __builtin_amdgcn_permlane16_swap(a.x, b.x, false, false); const auto ry = __builtin_amdgcn_permlane16_swap(a.y, b.y, false, false);
    return (u32x4){rx[0], ry[0], rx[1], ry[1]};
}
__device__ __forceinline__ float bf_lo(unsigned w) { return __uint_as_float(w << 16); }
__device__ __forceinline__ float bf_hi(unsigned w) { return __uint_as_float(w & 0xffff0000u); }
__device__ __forceinline__ float silu_f(float g) { return g * __builtin_amdgcn_rcpf(1.0f + __builtin_amdgcn_exp2f(-1.44269504f * g)); }
__device__ __forceinline__ float rstd_of(const float* ss, int row) {
    const f32x4* q = (const f32x4*)(ss + (size_t)row * 32); float s = 0.f;
#pragma unroll
    for (int j = 0; j < 8; ++j) { const f32x4 v = q[j]; s += (v[0] + v[1]) + (v[2] + v[3]); }
    return rsqrtf(s * (1.0f / 2048.0f) + EPS); }

namespace pg8 {
constexpr int BM = 256, BK = 64, HALF = 128, HTB = HALF * BK * 2, STAGE_BYTES = 8 * HTB, NXCD = 8, WGM = 8;
__device__ __forceinline__ int lds_byte(int r, int c) { const int st = (r >> 4) * 2 + (c >> 5), rr = r & 15, cc = c & 31, ob = rr * 64 + cc * 2; return st * 1024 + (ob ^ (((ob >> 9) & 1) << 5)); }
__device__ __forceinline__ void stage_rc(int b, int& R, int& C) { const int st = b / 1024, sb = b % 1024, swz = sb ^ (((sb >> 9) & 1) << 5); R = (st >> 1) * 16 + swz / 64; C = (st & 1) * 32 + (swz % 64) / 2; }
__device__ __forceinline__ int perm32(int rho) { const int n = rho >> 4, i = rho & 15; return 8 * (i >> 2) + 4 * n + (i & 3); }

struct Unit { int pm, pn, z; const char* a; const char* b; size_t o; int r0, c0; };

struct StdOrder {
    int nM, nN, nwg, G, c, wgm; const char* A; const char* B; size_t ta, tb, bbatch;
    __device__ void init(int M, int N, int G_, int c_, const void* A_, size_t lda, const void* B_, size_t ldb) { nM = M / BM; nN = N / BM; nwg = nM * nN; G = G_; c = c_; A = (const char*)A_; B = (const char*)B_; ta = (size_t)BM * lda * 2; tb = (size_t)BM * ldb * 2; bbatch = 0; wgm = WGM; }
    __device__ bool next(int i, Unit& u) const {
        const long L = (long)i * G + c; if (c >= G || L >= nwg) return false;
        int wgid = (int)L; { const int q = nwg / NXCD, r = nwg % NXCD, xcd = wgid % NXCD, off = wgid / NXCD; wgid = (xcd < r ? xcd * (q + 1) : r * (q + 1) + (xcd - r) * q) + off; }
        const int nig = wgm * nN, gid = wgid / nig, fm = gid * wgm, gsz = (nM - fm) < wgm ? (nM - fm) : wgm;
        u.pm = fm + ((wgid % nig) % gsz); u.pn = (wgid % nig) / gsz; u.z = 0; u.o = 0; u.r0 = 0; u.c0 = 0; u.a = A + (size_t)u.pm * ta; u.b = B + (size_t)u.pn * tb + ((u.pm >= (nM >> 1)) ? bbatch : (size_t)0); return true;
    }
};

template <bool ALIGN_EPI, class Epi, class Sched>
__device__ __forceinline__ void gemm_phase(LAS unsigned char* lds, const int lda, const int ldb, const int K, const Sched& S, const Epi& E, const size_t kstepA = (size_t)(BK * 2), const size_t kstepB = (size_t)(BK * 2)) {
    int tid = threadIdx.x; asm volatile("" : "+v"(tid));
    const int wid = __builtin_amdgcn_readfirstlane(tid >> 6), lane = tid & 63, wr = wid >> 2, wc = wid & 3, fr = lane & 15, fq = lane >> 4;
    const int nt = K / BK;
    unsigned voffA[2], voffB[2];
#pragma unroll
    for (int i = 0; i < 2; ++i) { int R, C; stage_rc(tid * 16 + i * 8192, R, C); const int Rb = (R & ~31) + perm32(R & 31);
        voffA[i] = (unsigned)(R * lda + C) * 2u; voffB[i] = (unsigned)(Rb * ldb + C) * 2u; }
    const size_t kstep = kstepB;
    const size_t hstepA = (size_t)HALF * lda * 2, hstepB = (size_t)HALF * ldb * 2;
    const unsigned ldsw = (unsigned)wid * 1024u;
    const int aoff = lds_byte(wr * 64 + fr, fq * 8), boff = lds_byte(wc * 32 + fr, fq * 8);
#define PG8_SA(b, h) (((b) * 2 + (h)) * HTB)
#define PG8_SB(b, h) ((4 + (b) * 2 + (h)) * HTB)
#define PG8_STAGE(bufoff, gbase, voff) do { _Pragma("unroll") for (int _i = 0; _i < 2; ++_i) \
        __builtin_amdgcn_global_load_lds((const unsigned*)((const char*)(gbase) + (voff)[_i]), (LAS unsigned*)(lds + (bufoff) + ldsw + _i * 8192), 16, 0, 0); } while (0)
#define PG8_LDA(dst, b, h) do { _Pragma("unroll") for (int m = 0; m < 4; ++m) _Pragma("unroll") for (int k = 0; k < 2; ++k) dst[m][k] = *(const LAS bf16x8*)(lds + PG8_SA(b, h) + aoff + m * 2048 + k * 1024); } while (0)
#define PG8_LDB(dst, b, h) do { _Pragma("unroll") for (int n = 0; n < 2; ++n) _Pragma("unroll") for (int k = 0; k < 2; ++k) dst[n][k] = *(const LAS bf16x8*)(lds + PG8_SB(b, h) + boff + n * 2048 + k * 1024); } while (0)
#define PG8_MMA(ai, bj, At, Bt) do { __builtin_amdgcn_s_setprio(1); _Pragma("unroll") for (int m = 0; m < 4; ++m) _Pragma("unroll") for (int n = 0; n < 2; ++n) _Pragma("unroll") for (int k = 0; k < 2; ++k) \
        acc[ai][bj][m][n] = __builtin_amdgcn_mfma_f32_16x16x32_bf16(Bt[n][k], At[m][k], acc[ai][bj][m][n], 0, 0, 0); __builtin_amdgcn_s_setprio(0); } while (0)
#define PG8_WAIT_V(n) asm volatile("s_waitcnt vmcnt(" #n ")" ::: "memory")
#define PG8_WAIT_L(n) asm volatile("s_waitcnt lgkmcnt(" #n ")" ::: "memory")
#define PG8_BAR __builtin_amdgcn_s_barrier()
#define PG8_SCHED __builtin_amdgcn_sched_barrier(0)
    Unit cur, nxt; int ui = 0;
    if (!S.next(0, cur)) return;
    f32x4 acc[2][2][4][2];
#pragma unroll
    for (int a = 0; a < 2; ++a)
#pragma unroll
        for (int b = 0; b < 2; ++b)
#pragma unroll
            for (int m = 0; m < 4; ++m)
#pragma unroll
                for (int n = 0; n < 2; ++n) acc[a][b][m][n] = (f32x4){0.f, 0.f, 0.f, 0.f};
    bf16x8 At[4][2], B0[2][2], B1[2][2];
    const char* cA = cur.a; const char* cB = cur.b;
    PG8_STAGE(PG8_SB(0, 0), cB, voffB); PG8_STAGE(PG8_SB(0, 1), cB + hstepB, voffB); PG8_STAGE(PG8_SA(0, 0), cA, voffA); PG8_STAGE(PG8_SA(0, 1), cA + hstepA, voffA);
    if (wr == 1) PG8_BAR;
    PG8_WAIT_V(2); PG8_BAR;
    PG8_STAGE(PG8_SB(1, 0), cB + kstep, voffB); PG8_STAGE(PG8_SA(1, 0), cA + kstepA, voffA); PG8_STAGE(PG8_SB(1, 1), cB + hstepB + kstep, voffB);
    PG8_WAIT_V(6); PG8_BAR;
    for (;;) {
        const bool has_next = S.next(ui + 1, nxt);
        const char* nA = has_next ? nxt.a : cA; const char* nB = has_next ? nxt.b : cB;
#pragma unroll 1
        for (int t = 0; t < nt; t += 2) {
            const bool last = (t == nt - 2);
            const char* a1 = cA + (size_t)(t + 1) * kstepA;
            const char* a2 = last ? nA : cA + (size_t)(t + 2) * kstepA; const char* b2 = last ? nB : cB + (size_t)(t + 2) * kstep;
            const char* a3 = a2 + kstepA; const char* b3 = b2 + kstep;
            PG8_LDB(B0, 0, 0); PG8_LDB(B1, 0, 1); PG8_SCHED; PG8_LDA(At, 0, 0); PG8_STAGE(PG8_SA(1, 1), a1 + hstepA, voffA);
            PG8_WAIT_V(8); PG8_WAIT_L(0); PG8_BAR; PG8_MMA(0, 0, At, B0); PG8_MMA(0, 1, At, B1); PG8_BAR; PG8_SCHED;
            PG8_LDA(At, 0, 1); PG8_STAGE(PG8_SB(0, 0), b2, voffB); PG8_STAGE(PG8_SB(0, 1), b2 + hstepB, voffB); PG8_STAGE(PG8_SA(0, 0), a2, voffA);
            PG8_WAIT_V(8); PG8_WAIT_L(0); PG8_BAR; PG8_MMA(1, 0, At, B0); PG8_MMA(1, 1, At, B1); PG8_BAR; PG8_SCHED;
            PG8_LDB(B0, 1, 0); PG8_LDB(B1, 1, 1); PG8_SCHED; PG8_LDA(At, 1, 0); PG8_STAGE(PG8_SA(0, 1), a2 + hstepA, voffA);
            PG8_WAIT_V(8); PG8_WAIT_L(0); PG8_BAR; PG8_MMA(0, 0, At, B0); PG8_MMA(0, 1, At, B1); PG8_BAR; PG8_SCHED;
            PG8_LDA(At, 1, 1); PG8_STAGE(PG8_SB(1, 0), b3, voffB); PG8_STAGE(PG8_SB(1, 1), b3 + hstepB, voffB); PG8_STAGE(PG8_SA(1, 0), a3, voffA);
            PG8_WAIT_V(8); PG8_WAIT_L(0); PG8_BAR; PG8_MMA(1, 0, At, B0); PG8_MMA(1, 1, At, B1); PG8_BAR; PG8_SCHED;
        }
        if constexpr (ALIGN_EPI) { if (wr == 0) PG8_BAR; }
        if constexpr (!Epi::AFTER_DRAIN) { E(acc, cur, wr, wc, fr, fq); }
        if (!has_next) break;
#pragma unroll
        for (int a = 0; a < 2; ++a)
#pragma unroll
            for (int b = 0; b < 2; ++b)
#pragma unroll
                for (int m = 0; m < 4; ++m)
#pragma unroll
                    for (int n = 0; n < 2; ++n) acc[a][b][m][n] = (f32x4){0.f, 0.f, 0.f, 0.f};
        cur = nxt; cA = nA; cB = nB; ++ui;
        if constexpr (ALIGN_EPI) { if (wr == 1) PG8_BAR; }
    }
    PG8_WAIT_V(0);
    if constexpr (!ALIGN_EPI) { if (wr == 0) PG8_BAR; }
    PG8_BAR;
    if constexpr (Epi::AFTER_DRAIN) { E.fused(acc, cur, wr, wc, fr, fq, lds, wid, lane); }
#undef PG8_SA
#undef PG8_SB
#undef PG8_STAGE
#undef PG8_LDA
#undef PG8_LDB
#undef PG8_MMA
#undef PG8_WAIT_V
#undef PG8_WAIT_L
#undef PG8_BAR
#undef PG8_SCHED
}

typedef f32x4 Acc[2][2][4][2];

struct EpiSwiglu {
    static constexpr bool AFTER_DRAIN = false;
    bf16_t* O; const float* ss;
    __device__ __forceinline__ void operator()(const Acc& acc, const Unit& u, int wr, int wc, int fr, int fq) const {
        const int row0 = u.pm * BM + wr * 64 + fr, col0 = u.pn * 128 + wc * 32 + 8 * fq;
#pragma unroll
        for (int ai = 0; ai < 2; ++ai)
#pragma unroll
            for (int m = 0; m < 4; ++m) { const int row = row0 + ai * HALF + m * 16; const float rs = ss ? rstd_of(ss, row) : 1.0f;
                const f32x4 g0 = acc[ai][0][m][0] * rs, g1 = acc[ai][0][m][1] * rs, u0 = acc[ai][1][m][0] * rs, u1 = acc[ai][1][m][1] * rs;
                u32x4 w; w.x = cvt_pk_bf16(silu_f(g0[0]) * u0[0], silu_f(g0[1]) * u0[1]); w.y = cvt_pk_bf16(silu_f(g0[2]) * u0[2], silu_f(g0[3]) * u0[3]);
                w.z = cvt_pk_bf16(silu_f(g1[0]) * u1[0], silu_f(g1[1]) * u1[1]); w.w = cvt_pk_bf16(silu_f(g1[2]) * u1[2], silu_f(g1[3]) * u1[3]);
                __builtin_nontemporal_store(w, (u32x4*)(O + ((size_t)(col0 >> 6) * T + row) * 64 + (col0 & 63))); }
    }
};
struct EpiResid {
    static constexpr bool AFTER_DRAIN = false;
    const float* xin; float* xout; bf16_t* xg; const float* gain; float* ss; float alpha;
    __device__ __forceinline__ void operator()(const Acc& acc, const Unit& u, int wr, int wc, int fr, int fq) const {
        const int row0 = u.pm * BM + wr * 64 + fr, col0 = u.pn * BM + wc * 32 + 8 * fq;
        f32x4 gv[2][2];
#pragma unroll
        for (int bj = 0; bj < 2; ++bj)
#pragma unroll
            for (int n = 0; n < 2; ++n) gv[bj][n] = xg ? *(const f32x4*)(gain + col0 + bj * HALF + 4 * n) : (f32x4){0.f, 0.f, 0.f, 0.f};
#pragma unroll
        for (int ai = 0; ai < 2; ++ai)
#pragma unroll
            for (int m = 0; m < 4; ++m) { const int row = row0 + ai * HALF + m * 16; const size_t off = (size_t)row * D + col0; float s = 0.f;
#pragma unroll
                for (int bj = 0; bj < 2; ++bj) {
                    const f32x4 x0 = *(const f32x4*)(xin + off + bj * HALF), x1 = *(const f32x4*)(xin + off + bj * HALF + 4);
                    const f32x4 y0 = x0 + acc[ai][bj][m][0] * alpha, y1 = x1 + acc[ai][bj][m][1] * alpha;
                    if (xout) { __builtin_nontemporal_store(y0, (f32x4*)(xout + off + bj * HALF)); __builtin_nontemporal_store(y1, (f32x4*)(xout + off + bj * HALF + 4)); }
                    s += (y0[0] * y0[0] + y0[1] * y0[1]) + (y0[2] * y0[2] + y0[3] * y0[3]) + (y1[0] * y1[0] + y1[1] * y1[1]) + (y1[2] * y1[2] + y1[3] * y1[3]);
                    if (xg) { const f32x4 a = y0 * gv[bj][0], b = y1 * gv[bj][1]; u32x4 w; w.x = cvt_pk_bf16(a[0], a[1]); w.y = cvt_pk_bf16(a[2], a[3]); w.z = cvt_pk_bf16(b[0], b[1]); w.w = cvt_pk_bf16(b[2], b[3]);
                        const int cx = col0 + bj * HALF; *(u32x4*)(xg + ((size_t)(cx >> 6) * T + row) * 64 + (cx & 63)) = w; } }
                s += __shfl_xor(s, 16); s += __shfl_xor(s, 32);
                if (fq == 0) ss[(size_t)row * 32 + u.pn * 4 + wc] = s;
                asm volatile("" ::: "memory"); }
    }
};
__device__ __forceinline__ void store_nat(const Acc& acc, bf16_t* base, size_t ldc, int row0, int col0, const float* ss) {
#pragma unroll
    for (int ai = 0; ai < 2; ++ai)
#pragma unroll
        for (int m = 0; m < 4; ++m) { const int row = row0 + ai * HALF + m * 16; const float rs = ss ? rstd_of(ss, row) : 1.0f;
#pragma unroll
            for (int bj = 0; bj < 2; ++bj) { const f32x4 a = acc[ai][bj][m][0] * rs, b = acc[ai][bj][m][1] * rs; u32x4 w; w.x = cvt_pk_bf16(a[0], a[1]); w.y = cvt_pk_bf16(a[2], a[3]); w.z = cvt_pk_bf16(b[0], b[1]); w.w = cvt_pk_bf16(b[2], b[3]);
                *(u32x4*)(base + (size_t)row * ldc + col0 + bj * HALF) = w; } }
}
struct EpiWin {
    static constexpr bool AFTER_DRAIN = false;
    bf16_t* P; bf16_t* KT; bf16_t* VT; const float* ss;
    __device__ __forceinline__ void operator()(const Acc& acc, const Unit& u, int wr, int wc, int fr, int fq) const {
        const int row0 = u.pm * BM + wr * 64 + fr;
        if (u.pn < 6 || u.pn >= 12) { store_nat(acc, P, 4096, row0, u.pn * BM + wc * 32 + 8 * fq, ss); return; }
        const bool isk = u.pn < 8;
#pragma unroll
        for (int ai = 0; ai < 2; ++ai) { const int chunk = u.pm * 4 + ai * 2 + wr;
#pragma unroll
            for (int m = 0; m < 4; ++m) { const int row = row0 + ai * HALF + m * 16; const float rs = rstd_of(ss, row); const int i = m * 16 + fr;
#pragma unroll
                for (int bj = 0; bj < 2; ++bj)
#pragma unroll
                    for (int n = 0; n < 2; ++n) { const f32x4 a = acc[ai][bj][m][n] * rs; const int c = bj * HALF + wc * 32 + 8 * fq + 4 * n;
                        bf16_t* dst;
                        if (isk) { const int kf = (u.pn - 6) * 256 + c; dst = KT + ((size_t)(chunk * 4 + (kf >> 7)) * 8192 + (size_t)(kf & 127) * 64 + i); }
                        else { dst = VT + ((size_t)(chunk * 4 + (u.pn - 8)) * 16384 + (size_t)c * 64 + i); }
                        const unsigned p0 = cvt_pk_bf16(a[0], a[1]), p1 = cvt_pk_bf16(a[2], a[3]);
                        dst[0] = (bf16_t)p0; dst[64] = (bf16_t)(p0 >> 16); dst[128] = (bf16_t)p1; dst[192] = (bf16_t)(p1 >> 16); } } }
    }
};
struct EpiMemKV {
    static constexpr bool AFTER_DRAIN = false;
    bf16_t* MK; bf16_t* MV;
    __device__ __forceinline__ void operator()(const Acc& acc, const Unit& u, int wr, int wc, int fr, int fq) const {
        const int h = (u.pn & 7) >> 1, d0 = (u.pn & 1) * 256; bf16_t* base = (u.pn < 8 ? MK : MV) + (size_t)(u.pm * 4 + h) * 256 * 512;
        store_nat(acc, base, 512, wr * 64 + fr, d0 + wc * 32 + 8 * fq, nullptr);
    }
};
struct EpiTile {
    static constexpr bool AFTER_DRAIN = false;
    bf16_t* O; size_t NR;
    __device__ __forceinline__ void operator()(const Acc& acc, const Unit& u, int wr, int wc, int fr, int fq) const {
        bf16_t* base = O + u.o;
#pragma unroll
        for (int ai = 0; ai < 2; ++ai)
#pragma unroll
            for (int m = 0; m < 4; ++m) { const int row = u.r0 + ai * HALF + wr * 64 + m * 16 + fr;
#pragma unroll
                for (int bj = 0; bj < 2; ++bj) { const int col = u.c0 + bj * HALF + wc * 32 + 8 * fq; const f32x4 a = acc[ai][bj][m][0], b = acc[ai][bj][m][1];
                    u32x4 w; w.x = cvt_pk_bf16(a[0], a[1]); w.y = cvt_pk_bf16(a[2], a[3]); w.z = cvt_pk_bf16(b[0], b[1]); w.w = cvt_pk_bf16(b[2], b[3]);
                    *(u32x4*)(base + ((size_t)(col >> 6) * NR + row) * 64 + (col & 63)) = w; } }
    }
};
struct EpiSoftmax {
    static constexpr bool AFTER_DRAIN = true;
    bf16_t* Pout; const float* ss;
    __device__ __forceinline__ void operator()(const Acc&, const Unit&, int, int, int, int) const {}
    __device__ __forceinline__ void fused(Acc& acc, const Unit& u, int wr, int wc, int fr, int fq, LAS unsigned char* lds, int wid, int lane) const {
        LAS float* X = (LAS float*)lds; LAS float* Y = (LAS float*)(lds + 4096);
        const float sc = 0.04419417382f * 1.44269504f;
#pragma unroll
        for (int ai = 0; ai < 2; ++ai)
#pragma unroll
            for (int m = 0; m < 4; ++m) { float mx = -3.0e38f; const float rs = rstd_of(ss, u.pm * BM + ai * HALF + wr * 64 + m * 16 + fr);
#pragma unroll
                for (int bj = 0; bj < 2; ++bj)
#pragma unroll
                    for (int n = 0; n < 2; ++n) { const f32x4 a = acc[ai][bj][m][n] * rs; acc[ai][bj][m][n] = a; mx = fmaxf(mx, fmaxf(fmaxf(a[0], a[1]), fmaxf(a[2], a[3]))); }
                mx = fmaxf(mx, __shfl_xor(mx, 16)); mx = fmaxf(mx, __shfl_xor(mx, 32));
                if (fq == 0) X[(ai * HALF + wr * 64 + m * 16 + fr) * 4 + wc] = mx; }
        asm volatile("s_waitcnt lgkmcnt(0)" ::: "memory"); __builtin_amdgcn_s_barrier(); asm volatile("" ::: "memory");
#pragma unroll
        for (int ai = 0; ai < 2; ++ai)
#pragma unroll
            for (int m = 0; m < 4; ++m) { const int r = ai * HALF + wr * 64 + m * 16 + fr; const f32x4 mv = *(const LAS f32x4*)(X + r * 4);
                const float rm = fmaxf(fmaxf(mv[0], mv[1]), fmaxf(mv[2], mv[3])) * sc; float s = 0.f;
#pragma unroll
                for (int bj = 0; bj < 2; ++bj)
#pragma unroll
                    for (int n = 0; n < 2; ++n) { f32x4 a = acc[ai][bj][m][n];
#pragma unroll
                        for (int j = 0; j < 4; ++j) { a[j] = __builtin_amdgcn_exp2f(a[j] * sc - rm); s += a[j]; }
                        acc[ai][bj][m][n] = a; }
                s += __shfl_xor(s, 16); s += __shfl_xor(s, 32);
                if (fq == 0) Y[r * 4 + wc] = s; }
        asm volatile("s_waitcnt lgkmcnt(0)" ::: "memory"); __builtin_amdgcn_s_barrier(); asm volatile("" ::: "memory");
        const int row0 = u.pm * BM + wr * 64 + fr, col0 = u.z * 256 + wc * 32 + 8 * fq;
#pragma unroll
        for (int ai = 0; ai < 2; ++ai)
#pragma unroll
            for (int m = 0; m < 4; ++m) { const int r = ai * HALF + wr * 64 + m * 16 + fr; const f32x4 sv = *(const LAS f32x4*)(Y + r * 4);
                const float inv = 1.0f / ((sv[0] + sv[1]) + (sv[2] + sv[3])); const int row = row0 + ai * HALF + m * 16;
#pragma unroll
                for (int bj = 0; bj < 2; ++bj) { const f32x4 a = acc[ai][bj][m][0] * inv, b = acc[ai][bj][m][1] * inv; u32x4 w; w.x = cvt_pk_bf16(a[0], a[1]); w.y = cvt_pk_bf16(a[2], a[3]); w.z = cvt_pk_bf16(b[0], b[1]); w.w = cvt_pk_bf16(b[2], b[3]);
                    const int cp = col0 + bj * HALF; *(u32x4*)(Pout + ((size_t)(cp >> 6) * T + row) * 64 + (cp & 63)) = w; } }
    }
};
struct WinFoldOrder {
    int c; const char* PW; const char* WINU;
    __device__ bool next(int i, Unit& u) const { if (i > 0 || c < 0 || c >= 32) return false; const int g = c >> 3; u.pm = g; u.z = 0; u.pn = c & 7;
        u.a = PW + (size_t)g * 65536 * 2; u.b = WINU + ((size_t)u.pn * 256 * 1024 + g * 256) * 2; u.o = 0; u.r0 = g * 256; u.c0 = u.pn * 256; return true; }
};
struct WqKOrder {
    int c; const char* MK; const char* WQN;
    __device__ bool next(int i, Unit& u) const { if (i > 0 || c < 0 || c >= 64) return false; const int b = c >> 5, h = (c >> 3) & 3; u.pm = b; u.z = h; u.pn = c & 7;
        u.a = MK + (size_t)((b * 4 + h) * 256 * 512) * 2; u.b = WQN + ((size_t)u.pn * 256 * D + h * 512) * 2; u.o = (size_t)b * 1024 * D; u.r0 = h * 256; u.c0 = u.pn * 256; return true; }
};
struct VWoOrder {
    int c; const char* WOT; const char* MV;
    __device__ bool next(int i, Unit& u) const { if (i > 0 || c < 0 || c >= 64) return false; const int b = c >> 5, h = (c >> 3) & 3; u.pm = c & 7; u.z = h; u.pn = 0;
        u.a = WOT + ((size_t)u.pm * 256 * D + h * 512) * 2; u.b = MV + (size_t)((b * 4 + h) * 256 * 512) * 2; u.o = (size_t)b * D * 1024; u.r0 = u.pm * 256; u.c0 = h * 256; return true; }
};
struct LogitOrder {
    int c; const char* A; const char* WQK;
    __device__ bool next(int i, Unit& u) const { if (i > 0 || c >= 256) return false; const int v = (c & 7) * 32 + (c >> 3); u.pm = v >> 2; u.z = v & 3; u.pn = 0; u.o = 0;
        u.a = A + (size_t)u.pm * 256 * 64 * 2; u.b = WQK + ((size_t)(u.pm >> 5) * 1024 * D + (size_t)u.z * 256 * 64) * 2; return true; }
};
struct MemKVOrder {
    int c; const char* A; const char* B;
    __device__ bool next(int i, Unit& u) const { if (i > 0 || c >= 32 || c < 0) return false; u.pm = c & 1; u.pn = c >> 1; u.z = 0; u.o = 0; u.a = A + (size_t)u.pm * 256 * D * 2; u.b = B + (size_t)u.pn * 256 * D * 2; return true; }
};
}

struct Params {
    const float *x, *mem, *ffn1_norm, *ffn1_wg, *ffn1_wu, *ffn1_wd, *mix_norm, *w_in, *pool_w, *pool_scale, *gla_w_a2, *gla_b_a, *gla_head_norm, *w_out,
        *xattn_norm, *mem_norm, *wq, *wkv, *wo, *ffn2_norm, *ffn2_wg, *ffn2_wu, *ffn2_wd, *final_norm;
    float* out; unsigned char* ws;
};

__device__ __forceinline__ float wave_sum(float v) {
#pragma unroll
    for (int o = 1; o < 64; o <<= 1) v += __shfl_xor(v, o);
    return v;
}

__device__ __forceinline__ void conv_item(const float* W, int K, int ld, int nblk, bf16_t* WT, int mode, LAS float* scr, int item, int lane, int tiledNR = 0) {
    const int kb = item / nblk, nb = item - kb * nblk, k0 = 64 * kb, n0 = 64 * nb;
    const float* src = W + (size_t)k0 * ld + n0 + lane;
    float tv[64];
#pragma unroll
    for (int kk = 0; kk < 64; ++kk) tv[kk] = __builtin_nontemporal_load(src + (size_t)kk * ld);
#pragma unroll
    for (int kk = 0; kk < 64; ++kk) scr[kk * 65 + lane] = tv[kk];
    asm volatile("s_waitcnt lgkmcnt(0)" ::: "memory");
    const int c = lane & 7;
    const int rbase = (mode == 0) ? n0 : ((n0 >> 7) * 256 + (n0 & 127) + (mode == 2 ? 128 : 0));
#pragma unroll
    for (int j = 0; j < 8; ++j) { const int n = (lane >> 3) + 8 * j; const LAS float* s = scr + (8 * c) * 65 + n;
        u32x4 o; o.x = cvt_pk_bf16(s[0], s[65]); o.y = cvt_pk_bf16(s[2 * 65], s[3 * 65]); o.z = cvt_pk_bf16(s[4 * 65], s[5 * 65]); o.w = cvt_pk_bf16(s[6 * 65], s[7 * 65]);
        if (tiledNR) *(u32x4*)(WT + ((size_t)(k0 >> 6) * tiledNR + rbase + n) * 64 + 8 * c) = o; else *(u32x4*)(WT + (size_t)(rbase + n) * K + k0 + 8 * c) = o; }
    asm volatile("s_waitcnt lgkmcnt(0)" ::: "memory");
}
template <bool TILED>
__device__ __forceinline__ void rms_row_to_bf16(const float* xrow, const float* gain, bf16_t* obase, int m, int lane) {
    f32x4 v[8]; float s = 0.f;
#pragma unroll
    for (int j = 0; j < 8; ++j) { v[j] = *(const f32x4*)(xrow + 4 * lane + 256 * j); s += (v[j][0] * v[j][0] + v[j][1] * v[j][1]) + (v[j][2] * v[j][2] + v[j][3] * v[j][3]); }
    const float rs = rsqrtf(wave_sum(s) * (1.0f / 2048.0f) + EPS);
#pragma unroll
    for (int j = 0; j < 8; ++j) { const f32x4 g = *(const f32x4*)(gain + 4 * lane + 256 * j); const f32x4 y = v[j] * g * rs; u32x2 w; w.x = cvt_pk_bf16(y[0], y[1]); w.y = cvt_pk_bf16(y[2], y[3]);
        const int c = 4 * lane + 256 * j;
        if (TILED) *(u32x2*)(obase + ((size_t)(c >> 6) * T + m) * 64 + (c & 63)) = w; else *(u32x2*)(obase + (size_t)m * D + c) = w; }
}

template <int W>
__device__ __forceinline__ void pool_elem(const bf16_t* PN, const float* pscale, bf16_t* MIX, int tA, int tB, bool hasB, int c) {
    const int tt[2] = {tA, hasB ? tB : tA};
    u32x4 cj[2][W]; int cnt[2];
#pragma unroll
    for (int q = 0; q < 2; ++q) { const int spos = tt[q] & (SEQ - 1); cnt[q] = (spos + 1 < W) ? spos + 1 : W; const char* up = (const char*)(PN + (size_t)tt[q] * 4096 + c);
#pragma unroll
        for (int j = 0; j < W; ++j) { const unsigned jj = (j < cnt[q]) ? (unsigned)j : 0u; cj[q][j] = *(const u32x4*)(up - jj * 8192u); } }
    const f32x4 p0 = *(const f32x4*)(pscale + c), p1 = *(const f32x4*)(pscale + c + 4);
#pragma unroll
    for (int q = 0; q < 2; ++q) { const float inv = 1.0f / (float)cnt[q];
        float s[8] = {0.f, 0.f, 0.f, 0.f, 0.f, 0.f, 0.f, 0.f};
#pragma unroll
        for (int j = 0; j < W; ++j) { const float m = (j < cnt[q]) ? 1.0f : 0.0f; const u32x4 v = cj[q][j];
            s[0] += m * bf_lo(v.x); s[1] += m * bf_hi(v.x); s[2] += m * bf_lo(v.y); s[3] += m * bf_hi(v.y);
            s[4] += m * bf_lo(v.z); s[5] += m * bf_hi(v.z); s[6] += m * bf_lo(v.w); s[7] += m * bf_hi(v.w); }
        const u32x4 z0 = cj[q][0];
        u32x4 w; w.x = cvt_pk_bf16((s[0] * inv - bf_lo(z0.x)) * p0[0], (s[1] * inv - bf_hi(z0.x)) * p0[1]); w.y = cvt_pk_bf16((s[2] * inv - bf_lo(z0.y)) * p0[2], (s[3] * inv - bf_hi(z0.y)) * p0[3]);
        w.z = cvt_pk_bf16((s[4] * inv - bf_lo(z0.z)) * p1[0], (s[5] * inv - bf_hi(z0.z)) * p1[1]); w.w = cvt_pk_bf16((s[6] * inv - bf_lo(z0.w)) * p1[2], (s[7] * inv - bf_hi(z0.w)) * p1[3]);
        if (q == 0 || hasB) *(u32x4*)(MIX + ((size_t)(c >> 6) * T + tt[q]) * 64 + (c & 63)) = w; }
}

#define XB_TMO      128
#define XB_XCNT(j)  (256  + 64 * (j))
#define XB_XSUB(j)  (1280 + 64 * (j))
#define XB_XGEN(j)  (2304 + 64 * (j))
#define XB_TOP      3328
#define XB_TOPGEN   3392
#define XCD_BAR_WORDS 3456
#define XB_SPIN_CAP (1u << 18)

__device__ __forceinline__ unsigned xb_ld(unsigned* p)              { return __hip_atomic_load(p, __ATOMIC_RELAXED, __HIP_MEMORY_SCOPE_AGENT); }
__device__ __forceinline__ unsigned xb_add(unsigned* p, unsigned v) { return __hip_atomic_fetch_add(p, v, __ATOMIC_RELAXED, __HIP_MEMORY_SCOPE_AGENT); }
__device__ __forceinline__ unsigned xb_xcc_id() { return (unsigned)__builtin_amdgcn_s_getreg((3 << 11) | 20) & 0xFu; }
#define XB_SPIN(cond, bar) do { unsigned _sp = 0; while (cond) { __builtin_amdgcn_s_sleep(1); \
    if ((++_sp & 255u) == 0u) { if (xb_ld(&(bar)[XB_TMO])) break; if (_sp > XB_SPIN_CAP) { atomicAdd(&(bar)[XB_TMO], 1u); break; } } } } while (0)

struct XcdBarrier {
    unsigned* bar; unsigned x;
    volatile LAS unsigned* st;
};

__device__ __forceinline__ XcdBarrier xcd_barrier_post(unsigned* bar, volatile LAS unsigned* st) {
    XcdBarrier b; b.bar = bar; b.x = xb_xcc_id(); b.st = st;
    if (threadIdx.x == 0) (void)xb_add(&bar[XB_XCNT(b.x)], 1u);
    return b;
}
__device__ __forceinline__ void xcd_barrier_complete(unsigned* bar, unsigned x, unsigned& nloc, unsigned& nx) {
    const unsigned G = gridDim.x * gridDim.y * gridDim.z;
    unsigned sum, cnt, mine, sp = 0u;
    for (;;) {
        sum = 0u; cnt = 0u; mine = 0u;
#pragma unroll
        for (unsigned j = 0; j < 16; ++j) { const unsigned c = xb_ld(&bar[XB_XCNT(j)]); sum += c; cnt += (c > 0u) ? 1u : 0u; mine = (j == x) ? c : mine; }
        if (sum == G) break;
        __builtin_amdgcn_s_sleep(1);
        if ((++sp & 255u) == 0u) { if (xb_ld(&bar[XB_TMO])) break; if (sp > XB_SPIN_CAP) { atomicAdd(&bar[XB_TMO], 1u); break; } }
    }
    nloc = mine > 0u ? mine : 1u; nx = cnt > 0u ? cnt : 1u;
}

__device__ __forceinline__ void xcd_barrier(const XcdBarrier& b) {
    asm volatile("s_waitcnt vmcnt(0)" ::: "memory");
    __syncthreads();
    if (threadIdx.x == 0) {
        unsigned* bar = b.bar;
        __builtin_amdgcn_s_waitcnt(0);
        unsigned nloc = b.st[0], nx = b.st[1];
        if (nloc == 0u) { xcd_barrier_complete(bar, b.x, nloc, nx); b.st[0] = nloc; b.st[1] = nx; }
        const unsigned old = xb_add(&bar[XB_XSUB(b.x)], 1u);
        const unsigned gen = old / nloc;
        if (old + 1u == (gen + 1u) * nloc) {
            __builtin_amdgcn_fence(__ATOMIC_RELEASE, "agent");
            asm volatile("s_waitcnt vmcnt(0)" ::: "memory");
            const unsigned og = xb_add(&bar[XB_TOP], 1u);
            const unsigned tg = og / nx;
            if (og + 1u == (tg + 1u) * nx) xb_add(&bar[XB_TOPGEN], 1u);
            else XB_SPIN(xb_ld(&bar[XB_TOPGEN]) == tg, bar);
            __builtin_amdgcn_fence(__ATOMIC_ACQUIRE, "agent");
            xb_add(&bar[XB_XGEN(b.x)], 1u);
            asm volatile("s_waitcnt vmcnt(0)" ::: "memory");
        } else {
            XB_SPIN(xb_ld(&bar[XB_XGEN(b.x)]) == gen, bar);
            __builtin_amdgcn_fence(__ATOMIC_ACQUIRE, "agent");
            asm volatile("s_waitcnt vmcnt(0)" ::: "memory");
        }
    }
    __syncthreads();
}

#define GRID_SYNC() xcd_barrier(xbar)
__global__ void __launch_bounds__(NTHR, 2) fwd_megakernel(Params p) {
    extern __shared__ __attribute__((aligned(16))) unsigned char lds_raw[];
    LAS unsigned char* lds = (LAS unsigned char*)lds_raw;
    cg::grid_group grid = cg::this_grid();
    const int tid = threadIdx.x, lane = tid & 63, wave = __builtin_amdgcn_readfirstlane(tid >> 6), fr = lane & 15, fq = lane >> 4;
    const int bx = blockIdx.x, G = gridDim.x;
    const int gw = bx * 8 + wave, NGW = G * 8;
    const size_t gtid = (size_t)bx * NTHR + tid, NGT = (size_t)G * NTHR;
    unsigned char* ws = p.ws;
    volatile LAS unsigned* xst = (volatile LAS unsigned*)(lds + 133120);
    if (tid < 2) xst[tid] = 0u;
    __syncthreads();
    XcdBarrier xbar = xcd_barrier_post((unsigned*)(ws + WS_BAR), xst);
    if (p.ws == nullptr) grid.sync();
    float* SS = (float*)(ws + WS_SS); float* ALR = (float*)(ws + WS_ALR); float* BEND = (float*)(ws + WS_BEND);
    bf16_t* MEMH = (bf16_t*)(ws + WS_MEMH); bf16_t* MEMK = (bf16_t*)(ws + WS_MEMK); bf16_t* MEMVT = (bf16_t*)(ws + WS_MEMVT);
    bf16_t* W1GU = (bf16_t*)(ws + WS_W1GU); bf16_t* W1D = (bf16_t*)(ws + WS_W1D); bf16_t* W2GU = (bf16_t*)(ws + WS_W2GU); bf16_t* W2D = (bf16_t*)(ws + WS_W2D);
    bf16_t* WIN = (bf16_t*)(ws + WS_WIN); bf16_t* WA = (bf16_t*)(ws + WS_WA); bf16_t* POOLW = (bf16_t*)(ws + WS_POOLW); bf16_t* WOUT = (bf16_t*)(ws + WS_WOUT);
    bf16_t* WQ = (bf16_t*)(ws + WS_WQ); bf16_t* WKV = (bf16_t*)(ws + WS_WKV); bf16_t* WO = (bf16_t*)(ws + WS_WO);
    bf16_t* H = (bf16_t*)(ws + WS_H); bf16_t* ACT = (bf16_t*)(ws + WS_ACT); bf16_t* MIX = (bf16_t*)(ws + WS_MIX);
    bf16_t* PN = ACT; bf16_t* KT = (bf16_t*)(ws + WS_ACT + ACT_KT); bf16_t* VT = (bf16_t*)(ws + WS_ACT + ACT_VT);
    bf16_t* PATT = (bf16_t*)(ws + WS_ACT + ACT_PATT); bf16_t* WQK = (bf16_t*)(ws + WS_ACT + ACT_WQK); bf16_t* VWOT = (bf16_t*)(ws + WS_ACT + ACT_VWOT);
    bf16_t* KV = H;

    {
        LAS float* scr = (LAS float*)(lds + wave * 16640);
        constexpr int I_FF = (D / 64) * (FF / 64);
        constexpr int I_IN = (D / 64) * (4096 / 64);
        constexpr int I_DD = (D / 64) * (D / 64);
        constexpr int I_INR = (D / 64) * (3072 / 64);
        constexpr int NITEMS = 6 * I_FF + I_INR + 64 + I_DD * 2 + I_IN;
        for (int it = gw; it < NITEMS; it += NGW) {
            int r = it;
            if (r < I_FF) { conv_item(p.ffn1_wg, D, FF, FF / 64, W1GU, 1, scr, r, lane, 2 * FF); continue; } r -= I_FF;
            if (r < I_FF) { conv_item(p.ffn1_wu, D, FF, FF / 64, W1GU, 2, scr, r, lane, 2 * FF); continue; } r -= I_FF;
            if (r < I_FF) { conv_item(p.ffn1_wd, FF, D, D / 64, W1D, 0, scr, r, lane, D); continue; } r -= I_FF;
            if (r < I_FF) { conv_item(p.ffn2_wg, D, FF, FF / 64, W2GU, 1, scr, r, lane, 2 * FF); continue; } r -= I_FF;
            if (r < I_FF) { conv_item(p.ffn2_wu, D, FF, FF / 64, W2GU, 2, scr, r, lane, 2 * FF); continue; } r -= I_FF;
            if (r < I_FF) { conv_item(p.ffn2_wd, FF, D, D / 64, W2D, 0, scr, r, lane, D); continue; } r -= I_FF;
            if (r < I_INR) { conv_item(p.w_in + 1024, D, 4112, 3072 / 64, WIN + (size_t)1024 * 64, 0, scr, r, lane, 4096); continue; } r -= I_INR;
            if (r < 64) { const int g = r >> 4; conv_item(p.pool_w + (size_t)g * 65536, 256, 256, 4, POOLW + (size_t)g * 65536, 0, scr, r & 15, lane); continue; } r -= 64;
            if (r < I_DD) { conv_item(p.w_out, D, D, D / 64, WOUT, 0, scr, r, lane, D); continue; } r -= I_DD;
            if (r < I_DD) { conv_item(p.wo, D, D, D / 64, WO, 0, scr, r, lane); continue; } r -= I_DD;
            conv_item(p.wkv, D, 4096, 4096 / 64, WKV, 0, scr, r, lane);
        }
        for (size_t i = gtid; i < (size_t)D * D / 8; i += NGT) { const f32x4 a = ((const f32x4*)p.wq)[2 * i], b = ((const f32x4*)p.wq)[2 * i + 1];
            u32x4 w; w.x = cvt_pk_bf16(a[0], a[1]); w.y = cvt_pk_bf16(a[2], a[3]); w.z = cvt_pk_bf16(b[0], b[1]); w.w = cvt_pk_bf16(b[2], b[3]); ((u32x4*)WQ)[i] = w; }
        for (size_t i = gtid; i < (size_t)D * 1024 / 8; i += NGT) { const size_t kd = i >> 7, c = (i & 127) * 8; const float* src = p.w_in + kd * 4112 + c;
            const f32x4 a = *(const f32x4*)src, b = *(const f32x4*)(src + 4);
            u32x4 w; w.x = cvt_pk_bf16(a[0], a[1]); w.y = cvt_pk_bf16(a[2], a[3]); w.z = cvt_pk_bf16(b[0], b[1]); w.w = cvt_pk_bf16(b[2], b[3]); ((u32x4*)MIX)[i] = w; }
        for (size_t i = gtid; i < 32768; i += NGT) { const int k = (int)(i >> 4), r = (int)(i & 15); WA[r * D + k] = (bf16_t)cvt_pk_bf16(p.w_in[(size_t)k * 4112 + 4096 + r], 0.f); }
        for (int m = gw; m < T + MEMT; m += NGW) {
            if (m < T) rms_row_to_bf16<true>(p.x + (size_t)m * D, p.ffn1_norm, H, m, lane);
            else rms_row_to_bf16<false>(p.mem + (size_t)(m - T) * D, p.mem_norm, MEMH, m - T, lane);
        }
    }
    GRID_SYNC();
    { pg8::StdOrder S; S.init(T, 2 * FF, G, bx, H, 64, W1GU, 64); pg8::EpiSwiglu E{ACT, nullptr}; pg8::gemm_phase<true>(lds, 64, 64, D, S, E, (size_t)T * 64 * 2, (size_t)2 * FF * 64 * 2); }
    GRID_SYNC();
    { pg8::StdOrder S; S.init(T, D, G, bx, ACT, 64, W1D, 64); S.wgm = 4; pg8::EpiResid E{p.x, p.out, H, p.mix_norm, SS, 0.5f}; pg8::gemm_phase<true>(lds, 64, 64, FF, S, E, (size_t)T * 64 * 2, (size_t)D * 64 * 2); }
    { pg8::WinFoldOrder S{bx, (const char*)POOLW, (const char*)MIX}; pg8::EpiTile E{WIN, (size_t)4096}; pg8::gemm_phase<true>(lds, 256, 1024, 256, S, E); }
    GRID_SYNC();
    {
        { pg8::StdOrder S; S.init(T, 4096, G, bx, H, 64, WIN, 64); pg8::EpiWin E{PN, KT, VT, SS}; pg8::gemm_phase<true>(lds, 64, 64, D, S, E, (size_t)T * 64 * 2, (size_t)4096 * 64 * 2); }
        {
            const int tb = wave & 3, kh = wave >> 2; const int tok = bx * 64 + tb * 16 + fr;
            const bf16_t* ap = H + ((size_t)(kh * 16) * T + tok) * 64 + fq * 8; const bf16_t* wp = WA + (size_t)fr * D + kh * 1024 + fq * 8;
            f32x4 acc = {0.f, 0.f, 0.f, 0.f};
#pragma unroll 8
            for (int ks = 0; ks < 32; ++ks) { const bf16x8 wf = *(const bf16x8*)(wp + ks * 32), af = *(const bf16x8*)(ap + (size_t)(ks >> 1) * T * 64 + (ks & 1) * 32); acc = __builtin_amdgcn_mfma_f32_16x16x32_bf16(wf, af, acc, 0, 0, 0); }
            LAS f32x4* ex = (LAS f32x4*)lds;
            if (kh == 1) ex[tb * 64 + lane] = acc;
            __syncthreads();
            if (kh == 0) { const f32x4 o = (acc + ex[tb * 64 + lane]) * rstd_of(SS, tok); *(f32x4*)(ALR + (size_t)tok * 16 + 4 * fq) = o; }
        }
    }
    GRID_SYNC();
    constexpr int GA = 224;
    if (bx >= GA) { pg8::MemKVOrder S{bx - GA, (const char*)MEMH, (const char*)WKV}; pg8::EpiMemKV E{MEMK, MEMVT}; pg8::gemm_phase<true>(lds, D, D, D, S, E); }
    else {
        LAS float* alr_s = (LAS float*)lds; LAS float* w2_s = (LAS float*)(lds + 4096); LAS float* ba_s = (LAS float*)(lds + 12288); LAS float* gsum = (LAS float*)(lds + 12800);
        LAS bf16_t* KD = (LAS bf16_t*)(lds + 16384);
        {
            const int h = bx & 3; const int k = tid & 127, fg = tid >> 7;
            { const int idx = tid * 4, r = idx >> 7, kk = idx & 127; *(LAS f32x4*)(w2_s + idx) = *(const f32x4*)(p.gla_w_a2 + r * 512 + h * 128 + kk); }
            const float bk = p.gla_b_a[h * 128 + k];
            __syncthreads();
            float w[16];
#pragma unroll
            for (int r = 0; r < 16; ++r) w[r] = w2_s[r * 128 + k];
            f32x4 n_alr = {0.f, 0.f, 0.f, 0.f}; u32x4 n_k0, n_k1; bf16x8 n_vf[2][2];
#define GLA_A_PREFETCH(uu) do { if (tid < 256) n_alr = ((const f32x4*)(ALR + (size_t)((uu) >> 2) * 64 * 16))[tid]; \
                { const u32x4* kp_ = (const u32x4*)(KT + (size_t)(uu) * 8192 + (size_t)k * 64 + fg * 16); n_k0 = kp_[0]; n_k1 = kp_[1]; } \
                _Pragma("unroll") for (int vv = 0; vv < 2; ++vv) _Pragma("unroll") for (int ks = 0; ks < 2; ++ks) \
                    n_vf[vv][ks] = *(const bf16x8*)(VT + (size_t)(uu) * 16384 + (size_t)((2 * wave + vv) * 16 + fr) * 64 + ks * 32 + fq * 8); } while (0)
            GLA_A_PREFETCH(bx);
            for (int u = bx; u < 1024; u += GA) {
                const f32x4 c_alr = n_alr; const u32x4 k0 = n_k0, k1 = n_k1; bf16x8 vf[2][2];
#pragma unroll
                for (int vv = 0; vv < 2; ++vv)
#pragma unroll
                    for (int ks = 0; ks < 2; ++ks) vf[vv][ks] = n_vf[vv][ks];
                if (u + GA < 1024) GLA_A_PREFETCH(u + GA);
                if (tid < 256) ((LAS f32x4*)alr_s)[tid] = c_alr;
                __syncthreads();
                float cum[16]; float run = 0.f;
#pragma unroll
                for (int ii = 0; ii < 16; ++ii) { const int i = fg * 16 + ii; float z = bk;
#pragma unroll
                    for (int r = 0; r < 16; ++r) z += alr_s[i * 16 + r] * w[r];
                    const float la = -(fmaxf(-z, 0.f) + __logf(1.0f + __expf(-fabsf(z)))) * (1.0f / 16.0f);
                    run += la; cum[ii] = run; }
                gsum[fg * 128 + k] = run;
                __syncthreads();
                float prefix = 0.f, total = 0.f;
#pragma unroll
                for (int f = 0; f < 4; ++f) { const float gsv = gsum[f * 128 + k]; total += gsv; if (f < fg) prefix += gsv; }
                if (fg == 0) BEND[(size_t)u * 128 + k] = total;
                { const unsigned kw[8] = {k0.x, k0.y, k0.z, k0.w, k1.x, k1.y, k1.z, k1.w}; unsigned ow[8];
#pragma unroll
                  for (int q = 0; q < 8; ++q) { const float d0 = __expf(total - (cum[2 * q] + prefix)), d1 = __expf(total - (cum[2 * q + 1] + prefix)); ow[q] = cvt_pk_bf16(bf_lo(kw[q]) * d0, bf_hi(kw[q]) * d1); }
                  LAS u32x4* dst = (LAS u32x4*)(KD + k * 72 + fg * 16); dst[0] = (u32x4){ow[0], ow[1], ow[2], ow[3]}; dst[1] = (u32x4){ow[4], ow[5], ow[6], ow[7]}; }
                __syncthreads();
#pragma unroll
                for (int kp = 0; kp < 4; ++kp) { u32x2 w0[2], w1[2];
#pragma unroll
                    for (int kq = 0; kq < 2; ++kq) { const int kb = 2 * kp + kq; f32x4 a0 = {0.f, 0.f, 0.f, 0.f}, a1 = {0.f, 0.f, 0.f, 0.f};
#pragma unroll
                        for (int ks = 0; ks < 2; ++ks) { const bf16x8 kf = *(const LAS bf16x8*)(KD + (kb * 16 + fr) * 72 + ks * 32 + fq * 8);
                            a0 = __builtin_amdgcn_mfma_f32_16x16x32_bf16(kf, vf[0][ks], a0, 0, 0, 0); a1 = __builtin_amdgcn_mfma_f32_16x16x32_bf16(kf, vf[1][ks], a1, 0, 0, 0); }
                        w0[kq].x = cvt_pk_bf16(a0[0], a0[1]); w0[kq].y = cvt_pk_bf16(a0[2], a0[3]); w1[kq].x = cvt_pk_bf16(a1[0], a1[1]); w1[kq].y = cvt_pk_bf16(a1[2], a1[3]); }
                    const int eo = kp * 32 + (fq & 1) * 16 + (fq >> 1) * 8;
                    *(u32x4*)(KV + (size_t)u * 32768 + (size_t)((2 * wave) * 16 + fr) * 128 + eo) = pair16(w0[0], w0[1]);
                    *(u32x4*)(KV + (size_t)u * 32768 + (size_t)((2 * wave + 1) * 16 + fr) * 128 + eo) = pair16(w1[0], w1[1]); }
                __syncthreads();
            }
#undef GLA_A_PREFETCH
        }
        { const int gwp = bx * 8 + wave; constexpr int NWP = GA * 8;
          for (int g = 0; g < 4; ++g)
            for (int tp = gwp; tp < 8192; tp += 2 * NWP) { const int tpB = tp + NWP; const bool hasB = tpB < 8192;
                const int tA = 2 * tp + (lane >> 5), tB = 2 * tpB + (lane >> 5), c = g * 256 + (lane & 31) * 8;
                if (g == 0) pool_elem<2>(PN, p.pool_scale, MIX, tA, tB, hasB, c);
                else if (g == 1) pool_elem<4>(PN, p.pool_scale, MIX, tA, tB, hasB, c);
                else if (g == 2) pool_elem<8>(PN, p.pool_scale, MIX, tA, tB, hasB, c);
                else pool_elem<16>(PN, p.pool_scale, MIX, tA, tB, hasB, c); } }
    }
    GRID_SYNC();
    {
        int t5 = threadIdx.x; asm volatile("" : "+v"(t5));
        if (bx < 128) {
            const int e = bx * NTHR + t5; const int bh = e >> 13, qd = e & 8191; const int b = bh >> 2, h = bh & 3; const int k = 4 * (qd & 31);
            f32x4 st = {0.f, 0.f, 0.f, 0.f};
            for (int c0 = 0; c0 < 128; c0 += 16) {
                u32x2 kvw[16]; f32x4 gm[16];
#pragma unroll
                for (int q = 0; q < 16; ++q) { const size_t u = (size_t)((b * 128 + c0 + q) * 4 + h); kvw[q] = *(const u32x2*)(KV + u * 32768 + 4 * qd); gm[q] = *(const f32x4*)(BEND + u * 128 + k); }
#pragma unroll
                for (int q = 0; q < 16; ++q) { const size_t u = (size_t)((b * 128 + c0 + q) * 4 + h);
                    st[0] = __expf(gm[q][0]) * st[0] + bf_lo(kvw[q].x); st[1] = __expf(gm[q][1]) * st[1] + bf_hi(kvw[q].x);
                    st[2] = __expf(gm[q][2]) * st[2] + bf_lo(kvw[q].y); st[3] = __expf(gm[q][3]) * st[3] + bf_hi(kvw[q].y);
                    u32x2 o; o.x = cvt_pk_bf16(st[0], st[1]); o.y = cvt_pk_bf16(st[2], st[3]);
                    *(u32x2*)(KV + u * 32768 + 4 * qd) = o; }
            }
        }
        { pg8::WqKOrder S{bx - 128, (const char*)MEMK, (const char*)WQ}; pg8::EpiTile E{WQK, (size_t)1024}; pg8::gemm_phase<true>(lds, 512, D, 512, S, E); }
        { pg8::VWoOrder S{bx - 192, (const char*)WO, (const char*)MEMVT}; pg8::EpiTile E{VWOT, (size_t)D}; pg8::gemm_phase<true>(lds, D, 512, 512, S, E); }
    }
    GRID_SYNC();
    {
        LAS float* exch = (LAS float*)lds;
        f32x4 hn[8];
#pragma unroll
        for (int vb = 0; vb < 8; ++vb) hn[vb] = *(const f32x4*)(p.gla_head_norm + (bx & 3) * 256 + (wave >> 2) * 128 + vb * 16 + 4 * fq);
        for (int u = bx; u < 1024; u += G) {
            const int h = u & 3, chunk = u >> 2; const int t0 = chunk * 64; const int tb = wave & 3, vh = wave >> 2; const int t = t0 + tb * 16 + fr;
            u32x2 gt[8];
#pragma unroll
            for (int vb = 0; vb < 8; ++vb) gt[vb] = *(const u32x2*)(PN + (size_t)t * 4096 + 3072 + h * 256 + vh * 128 + vb * 16 + 4 * fq);
            bf16x8 qf[4];
#pragma unroll
            for (int ks = 0; ks < 4; ++ks) qf[ks] = *(const bf16x8*)(PN + (size_t)t * 4096 + 1024 + h * 128 + ks * 32 + fq * 8);
            f32x4 acc[8]; float ssq = 0.f;
#pragma unroll
            for (int vb = 0; vb < 8; ++vb) { f32x4 a = {0.f, 0.f, 0.f, 0.f};
#pragma unroll
                for (int ks = 0; ks < 4; ++ks) { const bf16x8 sf = *(const bf16x8*)(KV + (size_t)u * 32768 + (size_t)((vh * 8 + vb) * 16 + fr) * 128 + ks * 32 + fq * 8); a = __builtin_amdgcn_mfma_f32_16x16x32_bf16(sf, qf[ks], a, 0, 0, 0); }
                a = a * 0.08838834764f; acc[vb] = a; ssq += (a[0] * a[0] + a[1] * a[1]) + (a[2] * a[2] + a[3] * a[3]); }
            ssq += __shfl_xor(ssq, 16); ssq += __shfl_xor(ssq, 32);
            if (fq == 0) exch[(vh * 4 + tb) * 16 + fr] = ssq;
            __syncthreads();
            const float tot = exch[tb * 16 + fr] + exch[(4 + tb) * 16 + fr]; const float rs = rsqrtf(tot * (1.0f / 256.0f) + EPS);
#pragma unroll
            for (int vp = 0; vp < 4; ++vp) { u32x2 w2[2];
#pragma unroll
                for (int vq = 0; vq < 2; ++vq) { const int vb = 2 * vp + vq; const u32x2 gw2 = gt[vb];
                    const f32x4 o = acc[vb] * rs * hn[vb]; w2[vq].x = cvt_pk_bf16(o[0] * silu_f(bf_lo(gw2.x)), o[1] * silu_f(bf_hi(gw2.x))); w2[vq].y = cvt_pk_bf16(o[2] * silu_f(bf_lo(gw2.y)), o[3] * silu_f(bf_hi(gw2.y))); }
                const int cm = 1024 + h * 256 + vh * 128 + vp * 32 + (fq & 1) * 16 + (fq >> 1) * 8;
                *(u32x4*)(MIX + ((size_t)(cm >> 6) * T + t) * 64 + (cm & 63)) = pair16(w2[0], w2[1]); }
            __syncthreads();
        }
    }
    GRID_SYNC();
    { pg8::StdOrder S; S.init(T, D, G, bx, MIX, 64, WOUT, 64); pg8::EpiResid E{p.out, p.out, H, p.xattn_norm, SS + 32 * T, 1.0f}; pg8::gemm_phase<true>(lds, 64, 64, D, S, E, (size_t)T * 64 * 2, (size_t)D * 64 * 2); }
    GRID_SYNC();
    { pg8::LogitOrder S{bx, (const char*)H, (const char*)WQK}; pg8::EpiSoftmax E{PATT, SS + 32 * T}; pg8::gemm_phase<false>(lds, 64, 64, D, S, E, (size_t)T * 64 * 2, (size_t)1024 * 64 * 2); }
    GRID_SYNC();
    { pg8::StdOrder S; S.init(T, D, G, bx, PATT, 64, VWOT, 64); S.bbatch = (size_t)D * 1024 * 2; pg8::EpiResid E{p.out, p.out, H, p.ffn2_norm, SS + 64 * T, 1.0f}; pg8::gemm_phase<true>(lds, 64, 64, 1024, S, E, (size_t)T * 64 * 2, (size_t)D * 64 * 2); }
    GRID_SYNC();
    { pg8::StdOrder S; S.init(T, 2 * FF, G, bx, H, 64, W2GU, 64); pg8::EpiSwiglu E{ACT, SS + 64 * T}; pg8::gemm_phase<true>(lds, 64, 64, D, S, E, (size_t)T * 64 * 2, (size_t)2 * FF * 64 * 2); }
    GRID_SYNC();
    { pg8::StdOrder S; S.init(T, D, G, bx, ACT, 64, W2D, 64); S.wgm = 4; pg8::EpiResid E{p.out, nullptr, H, p.final_norm, SS + 96 * T, 0.5f};   pg8::gemm_phase<true>(lds, 64, 64, FF, S, E, (size_t)T * 64 * 2, (size_t)D * 64 * 2); }
    GRID_SYNC();
    { int t14 = threadIdx.x; asm volatile("" : "+v"(t14)); const int l14 = t14 & 63, gw14 = blockIdx.x * 8 + (t14 >> 6);
      const float* ss3 = SS + 96 * T;
      for (int m = gw14; m < T; m += NGW) {
          const float part = (l14 < 32) ? ss3[(size_t)m * 32 + l14] : 0.f; const float rs = rsqrtf(wave_sum(part) * (1.0f / 2048.0f) + EPS);
#pragma unroll
          for (int j4 = 0; j4 < 4; ++j4) { const int col = (l14 + 64 * j4) * 8; const u32x4 w = *(const u32x4*)(H + ((size_t)(col >> 6) * T + m) * 64 + (col & 63));
              f32x4 a, b; a[0] = bf_lo(w.x) * rs; a[1] = bf_hi(w.x) * rs; a[2] = bf_lo(w.y) * rs; a[3] = bf_hi(w.y) * rs; b[0] = bf_lo(w.z) * rs; b[1] = bf_hi(w.z) * rs; b[2] = bf_lo(w.w) * rs; b[3] = bf_hi(w.w) * rs;
              *(f32x4*)(p.out + (size_t)m * D + col) = a; *(f32x4*)(p.out + (size_t)m * D + col + 4) = b; } } }
}

extern "C" void kernel_launch(void* const* d_in, const int* in_sizes, int n_in, void* d_out, int out_size, void* d_ws, size_t ws_size, hipStream_t stream) {
    static int grid = 0;
    if (grid == 0) {
        if (n_in != 24 || out_size != T * D || ws_size < WS_END) { fprintf(stderr, "kernel_launch: unexpected shapes n_in %d out %d ws %zu (need %zu)\n", n_in, out_size, ws_size, (size_t)WS_END); grid = -1; return; }
        int dev = 0, cus = 0, per_cu = 0;
        (void)hipGetDevice(&dev); (void)hipDeviceGetAttribute(&cus, hipDeviceAttributeMultiprocessorCount, dev);
        (void)hipFuncSetAttribute((const void*)fwd_megakernel, hipFuncAttributeMaxDynamicSharedMemorySize, LDS_BYTES);
        (void)hipOccupancyMaxActiveBlocksPerMultiprocessor(&per_cu, (const void*)fwd_megakernel, NTHR, LDS_BYTES);
        (void)hipGetLastError();
        grid = cus < NWG ? cus : NWG;
        if (per_cu < 1) fprintf(stderr, "kernel_launch: occupancy query says %d blocks/CU\n", per_cu);
    }
    if (grid < 0) return;
    if (hipMemsetAsync((char*)d_ws + WS_BAR, 0, 16384, stream) != hipSuccess) { fprintf(stderr, "kernel_launch: memset failed\n"); return; }
    Params p{};
    const float** pp = (const float**)&p;
    for (int i = 0; i < 24; ++i) pp[i] = (const float*)d_in[i];
    p.out = (float*)d_out; p.ws = (unsigned char*)d_ws;
    void* args[] = {&p};
    hipError_t e = hipLaunchCooperativeKernel((const void*)fwd_megakernel, dim3(grid), dim3(NTHR), args, LDS_BYTES, stream);
    if (e != hipSuccess) fprintf(stderr, "cooperative launch failed: %s (grid %d)\n", hipGetErrorString(e), grid);
}
```

```cpp
#include <hip/hip_runtime.h>
#include <hip/hip_cooperative_groups.h>
#include <cstdio>
#include <cstdint>
namespace cg = cooperative_groups;

#define LAS __attribute__((address_space(3)))
typedef unsigned short bf16_t;
typedef short bf16x8 __attribute__((ext_vector_type(8)));
typedef float f32x4 __attribute__((ext_vector_type(4)));
typedef float f32x2 __attribute__((ext_vector_type(2)));
typedef unsigned u32x4 __attribute__((ext_vector_type(4)));
typedef unsigned u32x2 __attribute__((ext_vector_type(2)));

constexpr int T = 16384, D = 2048, FF = 5632, SEQ = 8192, MEMT = 512;
constexpr int NWG = 256, NTHR = 512;
constexpr float EPS = 1e-6f;

constexpr size_t WS_BAR   = 0;
constexpr size_t WS_SS    = 16384;
constexpr size_t WS_ALR   = WS_SS + 4ull * T * 32 * 4;
constexpr size_t WS_BEND  = WS_ALR + (size_t)T * 16 * 4;
constexpr size_t WS_MEMH  = WS_BEND + 1024ull * 128 * 4;
constexpr size_t WS_MEMK  = WS_MEMH + (size_t)MEMT * D * 2;
constexpr size_t WS_MEMVT = WS_MEMK + (size_t)MEMT * D * 2;
constexpr size_t WS_W1GU  = WS_MEMVT + (size_t)MEMT * D * 2;
constexpr size_t WS_W1D   = WS_W1GU + 2ull * FF * D * 2;
constexpr size_t WS_W2GU  = WS_W1D + (size_t)FF * D * 2;
constexpr size_t WS_W2D   = WS_W2GU + 2ull * FF * D * 2;
constexpr size_t WS_WIN   = WS_W2D + (size_t)FF * D * 2;
constexpr size_t WS_WA    = WS_WIN + 4096ull * D * 2;
constexpr size_t WS_POOLW = WS_WA + 16ull * D * 2;
constexpr size_t WS_WOUT  = WS_POOLW + 4ull * 256 * 256 * 2;
constexpr size_t WS_WQ    = WS_WOUT + (size_t)D * D * 2;
constexpr size_t WS_WKV   = WS_WQ + (size_t)D * D * 2;
constexpr size_t WS_WO    = WS_WKV + 2ull * D * D * 2;
constexpr size_t WS_H     = WS_WO + (size_t)D * D * 2;
constexpr size_t WS_ACT   = WS_H + (size_t)T * D * 2;
constexpr size_t WS_MIX   = WS_ACT + (size_t)T * FF * 2;
constexpr size_t WS_RS0   = WS_MIX + (size_t)T * D * 2;
constexpr size_t WS_END   = WS_RS0 + (size_t)T * 4;
constexpr size_t ACT_KT   = (size_t)T * 4096 * 2;
constexpr size_t ACT_VT   = ACT_KT + 1024ull * 8192 * 2;
constexpr size_t ACT_PATT = (size_t)T * D * 2;
constexpr size_t ACT_WQK  = ACT_KT;
constexpr size_t ACT_VWOT = ACT_WQK + 2ull * 1024 * D * 2;

constexpr int LDS_BYTES = 139264;

typedef __bf16 bf16x2_t __attribute__((ext_vector_type(2)));
__device__ __forceinline__ unsigned cvt_pk_bf16(float lo, float hi) { const f32x2 v = {lo, hi}; const bf16x2_t r = __builtin_convertvector(v, bf16x2_t); return __builtin_bit_cast(unsigned, r); }
__device__ __forceinline__ u32x4 pair16(u32x2 a, u32x2 b) {
    const auto rx = __builtin_amdgcn_permlane16_swap(a.x, b.x, false, false); const auto ry = __builtin_amdgcn_permlane16_swap(a.y, b.y, false, false);
    return (u32x4){rx[0], ry[0], rx[1], ry[1]};
}
__device__ __forceinline__ float bf_lo(unsigned w) { return __uint_as_float(w << 16); }
__device__ __forceinline__ float bf_hi(unsigned w) { return __uint_as_float(w & 0xffff0000u); }
__device__ __forceinline__ float silu_f(float g) { return g * __builtin_amdgcn_rcpf(1.0f + __builtin_amdgcn_exp2f(-1.44269504f * g)); }
__device__ __forceinline__ float rstd_of(const float* ss, int row) {
    const f32x4* q = (const f32x4*)(ss + (size_t)row * 32); float s = 0.f;
#pragma unroll
    for (int j = 0; j < 8; ++j) { const f32x4 v = q[j]; s += (v[0] + v[1]) + (v[2] + v[3]); }
    return rsqrtf(s * (1.0f / 2048.0f) + EPS); }

namespace pg8 {
constexpr int BM = 256, BK = 64, HALF = 128, HTB = HALF * BK * 2, STAGE_BYTES = 8 * HTB, NXCD = 8, WGM = 8;
__device__ __forceinline__ int lds_byte(int r, int c) { const int st = (r >> 4) * 2 + (c >> 5), rr = r & 15, cc = c & 31, ob = rr * 64 + cc * 2; return st * 1024 + (ob ^ (((ob >> 9) & 1) << 5)); }
__device__ __forceinline__ void stage_rc(int b, int& R, int& C) { const int st = b / 1024, sb = b % 1024, swz = sb ^ (((sb >> 9) & 1) << 5); R = (st >> 1) * 16 + swz / 64; C = (st & 1) * 32 + (swz % 64) / 2; }
__device__ __forceinline__ int perm32(int rho) { const int n = rho >> 4, i = rho & 15; return 8 * (i >> 2) + 4 * n + (i & 3); }

struct Unit { int pm, pn, z; const char* a; const char* b; size_t o; int r0, c0; };

struct StdOrder {
    int nM, nN, nwg, G, c, wgm; const char* A; const char* B; size_t ta, tb, bbatch;
    __device__ void init(int M, int N, int G_, int c_, const void* A_, size_t lda, const void* B_, size_t ldb) { nM = M / BM; nN = N / BM; nwg = nM * nN; G = G_; c = c_; A = (const char*)A_; B = (const char*)B_; ta = (size_t)BM * lda * 2; tb = (size_t)BM * ldb * 2; bbatch = 0; wgm = WGM; }
    __device__ bool next(int i, Unit& u) const {
        const long L = (long)i * G + c; if (c >= G || L >= nwg) return false;
        int wgid = (int)L; { const int q = nwg / NXCD, r = nwg % NXCD, xcd = wgid % NXCD, off = wgid / NXCD; wgid = (xcd < r ? xcd * (q + 1) : r * (q + 1) + (xcd - r) * q) + off; }
        const int nig = wgm * nN, gid = wgid / nig, fm = gid * wgm, gsz = (nM - fm) < wgm ? (nM - fm) : wgm;
        u.pm = fm + ((wgid % nig) % gsz); u.pn = (wgid % nig) / gsz; u.z = 0; u.o = 0; u.r0 = 0; u.c0 = 0; u.a = A + (size_t)u.pm * ta; u.b = B + (size_t)u.pn * tb + ((u.pm >= (nM >> 1)) ? bbatch : (size_t)0); return true;
    }
};

template <bool ALIGN_EPI, class Epi, class Sched>
__device__ __forceinline__ void gemm_phase(LAS unsigned char* lds, const int lda, const int ldb, const int K, const Sched& S, const Epi& E, const size_t kstepA = (size_t)(BK * 2), const size_t kstepB = (size_t)(BK * 2)) {
    int tid = threadIdx.x; asm volatile("" : "+v"(tid));
    const int wid = __builtin_amdgcn_readfirstlane(tid >> 6), lane = tid & 63, wr = wid >> 2, wc = wid & 3, fr = lane & 15, fq = lane >> 4;
    const int nt = K / BK;
    unsigned voffA[2], voffB[2];
#pragma unroll
    for (int i = 0; i < 2; ++i) { int R, C; stage_rc(tid * 16 + i * 8192, R, C); const int Rb = (R & ~31) + perm32(R & 31);
        voffA[i] = (unsigned)(R * lda + C) * 2u; voffB[i] = (unsigned)(Rb * ldb + C) * 2u; }
    const size_t kstep = kstepB;
    const size_t hstepA = (size_t)HALF * lda * 2, hstepB = (size_t)HALF * ldb * 2;
    const unsigned ldsw = (unsigned)wid * 1024u;
    const int aoff = lds_byte(wr * 64 + fr, fq * 8), boff = lds_byte(wc * 32 + fr, fq * 8);
#define PG8_SA(b, h) (((b) * 2 + (h)) * HTB)
#define PG8_SB(b, h) ((4 + (b) * 2 + (h)) * HTB)
#define PG8_STAGE(bufoff, gbase, voff) do { _Pragma("unroll") for (int _i = 0; _i < 2; ++_i) \
        __builtin_amdgcn_global_load_lds((const unsigned*)((const char*)(gbase) + (voff)[_i]), (LAS unsigned*)(lds + (bufoff) + ldsw + _i * 8192), 16, 0, 0); } while (0)
#define PG8_LDA(dst, b, h) do { _Pragma("unroll") for (int m = 0; m < 4; ++m) _Pragma("unroll") for (int k = 0; k < 2; ++k) dst[m][k] = *(const LAS bf16x8*)(lds + PG8_SA(b, h) + aoff + m * 2048 + k * 1024); } while (0)
#define PG8_LDB(dst, b, h) do { _Pragma("unroll") for (int n = 0; n < 2; ++n) _Pragma("unroll") for (int k = 0; k < 2; ++k) dst[n][k] = *(const LAS bf16x8*)(lds + PG8_SB(b, h) + boff + n * 2048 + k * 1024); } while (0)
#define PG8_MMA(ai, bj, At, Bt) do { __builtin_amdgcn_s_setprio(1); _Pragma("unroll") for (int m = 0; m < 4; ++m) _Pragma("unroll") for (int n = 0; n < 2; ++n) _Pragma("unroll") for (int k = 0; k < 2; ++k) \
        acc[ai][bj][m][n] = __builtin_amdgcn_mfma_f32_16x16x32_bf16(Bt[n][k], At[m][k], acc[ai][bj][m][n], 0, 0, 0); __builtin_amdgcn_s_setprio(0); } while (0)
#define PG8_WAIT_V(n) asm volatile("s_waitcnt vmcnt(" #n ")" ::: "memory")
#define PG8_WAIT_L(n) asm volatile("s_waitcnt lgkmcnt(" #n ")" ::: "memory")
#define PG8_BAR __builtin_amdgcn_s_barrier()
#define PG8_SCHED __builtin_amdgcn_sched_barrier(0)
    Unit cur, nxt; int ui = 0;
    if (!S.next(0, cur)) return;
    f32x4 acc[2][2][4][2];
#pragma unroll
    for (int a = 0; a < 2; ++a)
#pragma unroll
        for (int b = 0; b < 2; ++b)
#pragma unroll
            for (int m = 0; m < 4; ++m)
#pragma unroll
                for (int n = 0; n < 2; ++n) acc[a][b][m][n] = (f32x4){0.f, 0.f, 0.f, 0.f};
    bf16x8 At[4][2], B0[2][2], B1[2][2];
    const char* cA = cur.a; const char* cB = cur.b;
    PG8_STAGE(PG8_SB(0, 0), cB, voffB); PG8_STAGE(PG8_SB(0, 1), cB + hstepB, voffB); PG8_STAGE(PG8_SA(0, 0), cA, voffA); PG8_STAGE(PG8_SA(0, 1), cA + hstepA, voffA);
    if (wr == 1) PG8_BAR;
    PG8_WAIT_V(2); PG8_BAR;
    PG8_STAGE(PG8_SB(1, 0), cB + kstep, voffB); PG8_STAGE(PG8_SA(1, 0), cA + kstepA, voffA); PG8_STAGE(PG8_SB(1, 1), cB + hstepB + kstep, voffB);
    PG8_WAIT_V(6); PG8_BAR;
    for (;;) {
        const bool has_next = S.next(ui + 1, nxt);
        const char* nA = has_next ? nxt.a : cA; const char* nB = has_next ? nxt.b : cB;
#pragma unroll 1
        for (int t = 0; t < nt; t += 2) {
            const bool last = (t == nt - 2);
            const char* a1 = cA + (size_t)(t + 1) * kstepA;
            const char* a2 = last ? nA : cA + (size_t)(t + 2) * kstepA; const char* b2 = last ? nB : cB + (size_t)(t + 2) * kstep;
            const char* a3 = a2 + kstepA; const char* b3 = b2 + kstep;
            PG8_LDB(B0, 0, 0); PG8_LDB(B1, 0, 1); PG8_SCHED; PG8_LDA(At, 0, 0); PG8_STAGE(PG8_SA(1, 1), a1 + hstepA, voffA);
            PG8_WAIT_V(8); PG8_WAIT_L(0); PG8_BAR; PG8_MMA(0, 0, At, B0); PG8_MMA(0, 1, At, B1); PG8_BAR; PG8_SCHED;
            PG8_LDA(At, 0, 1); PG8_STAGE(PG8_SB(0, 0), b2, voffB); PG8_STAGE(PG8_SB(0, 1), b2 + hstepB, voffB); PG8_STAGE(PG8_SA(0, 0), a2, voffA);
            PG8_WAIT_V(8); PG8_WAIT_L(0); PG8_BAR; PG8_MMA(1, 0, At, B0); PG8_MMA(1, 1, At, B1); PG8_BAR; PG8_SCHED;
            PG8_LDB(B0, 1, 0); PG8_LDB(B1, 1, 1); PG8_SCHED; PG8_LDA(At, 1, 0); PG8_STAGE(PG8_SA(0, 1), a2 + hstepA, voffA);
            PG8_WAIT_V(8); PG8_WAIT_L(0); PG8_BAR; PG8_MMA(0, 0, At, B0); PG8_MMA(0, 1, At, B1); PG8_BAR; PG8_SCHED;
            PG8_LDA(At, 1, 1); PG8_STAGE(PG8_SB(1, 0), b3, voffB); PG8_STAGE(PG8_SB(1, 1), b3 + hstepB, voffB); PG8_STAGE(PG8_SA(1, 0), a3, voffA);
            PG8_WAIT_V(8); PG8_WAIT_L(0); PG8_BAR; PG8_MMA(1, 0, At, B0); PG8_MMA(1, 1, At, B1); PG8_BAR; PG8_SCHED;
        }
        if constexpr (ALIGN_EPI) { if (wr == 0) PG8_BAR; }
        if constexpr (!Epi::AFTER_DRAIN) { E(acc, cur, wr, wc, fr, fq); }
        if (!has_next) break;
#pragma unroll
        for (int a = 0; a < 2; ++a)
#pragma unroll
            for (int b = 0; b < 2; ++b)
#pragma unroll
                for (int m = 0; m < 4; ++m)
#pragma unroll
                    for (int n = 0; n < 2; ++n) acc[a][b][m][n] = (f32x4){0.f, 0.f, 0.f, 0.f};
        cur = nxt; cA = nA; cB = nB; ++ui;
        if constexpr (ALIGN_EPI) { if (wr == 1) PG8_BAR; }
    }
    PG8_WAIT_V(0);
    if constexpr (!ALIGN_EPI) { if (wr == 0) PG8_BAR; }
    PG8_BAR;
    if constexpr (Epi::AFTER_DRAIN) { E.fused(acc, cur, wr, wc, fr, fq, lds, wid, lane); }
#undef PG8_SA
#undef PG8_SB
#undef PG8_STAGE
#undef PG8_LDA
#undef PG8_LDB
#undef PG8_MMA
#undef PG8_WAIT_V
#undef PG8_WAIT_L
#undef PG8_BAR
#undef PG8_SCHED
}

typedef f32x4 Acc[2][2][4][2];

struct EpiSwiglu {
    static constexpr bool AFTER_DRAIN = false;
    bf16_t* O; const float* ss;
    __device__ __forceinline__ void operator()(const Acc& acc, const Unit& u, int wr, int wc, int fr, int fq) const {
        const int row0 = u.pm * BM + wr * 64 + fr, col0 = u.pn * 128 + wc * 32 + 8 * fq;
#pragma unroll
        for (int ai = 0; ai < 2; ++ai)
#pragma unroll
            for (int m = 0; m < 4; ++m) { const int row = row0 + ai * HALF + m * 16; const float rs = ss ? rstd_of(ss, row) : 1.0f;
                const f32x4 g0 = acc[ai][0][m][0] * rs, g1 = acc[ai][0][m][1] * rs, u0 = acc[ai][1][m][0] * rs, u1 = acc[ai][1][m][1] * rs;
                u32x4 w; w.x = cvt_pk_bf16(silu_f(g0[0]) * u0[0], silu_f(g0[1]) * u0[1]); w.y = cvt_pk_bf16(silu_f(g0[2]) * u0[2], silu_f(g0[3]) * u0[3]);
                w.z = cvt_pk_bf16(silu_f(g1[0]) * u1[0], silu_f(g1[1]) * u1[1]); w.w = cvt_pk_bf16(silu_f(g1[2]) * u1[2], silu_f(g1[3]) * u1[3]);
                *(u32x4*)(O + ((size_t)(col0 >> 6) * T + row) * 64 + (col0 & 63)) = w; }
    }
};
struct EpiResid {
    static constexpr bool AFTER_DRAIN = false;
    bf16_t* xs; const float* gprev; const float* rsprev; const float* gain; float* ss; float alpha;
    __device__ __forceinline__ void operator()(const Acc& acc, const Unit& u, int wr, int wc, int fr, int fq) const {
        const int row0 = u.pm * BM + wr * 64 + fr, col0 = u.pn * BM + wc * 32 + 8 * fq;
        f32x4 gv[2][2], gi[2][2];
#pragma unroll
        for (int bj = 0; bj < 2; ++bj)
#pragma unroll
            for (int n = 0; n < 2; ++n) { gv[bj][n] = *(const f32x4*)(gain + col0 + bj * HALF + 4 * n); const f32x4 gp = *(const f32x4*)(gprev + col0 + bj * HALF + 4 * n);
                gi[bj][n] = (f32x4){1.0f / gp[0], 1.0f / gp[1], 1.0f / gp[2], 1.0f / gp[3]}; }
#pragma unroll
        for (int ai = 0; ai < 2; ++ai)
#pragma unroll
            for (int m = 0; m < 4; ++m) { const int row = row0 + ai * HALF + m * 16; const float rinv = rsprev ? 1.0f / rsprev[row] : 1.0f; float s = 0.f;
#pragma unroll
                for (int bj = 0; bj < 2; ++bj) { const int cx = col0 + bj * HALF; bf16_t* px = xs + ((size_t)(cx >> 6) * T + row) * 64 + (cx & 63);
                    const u32x4 pv = *(const u32x4*)px;
                    const f32x4 x0 = (f32x4){bf_lo(pv.x), bf_hi(pv.x), bf_lo(pv.y), bf_hi(pv.y)} * gi[bj][0] * rinv, x1 = (f32x4){bf_lo(pv.z), bf_hi(pv.z), bf_lo(pv.w), bf_hi(pv.w)} * gi[bj][1] * rinv;
                    const f32x4 y0 = x0 + acc[ai][bj][m][0] * alpha, y1 = x1 + acc[ai][bj][m][1] * alpha;
                    s += (y0[0] * y0[0] + y0[1] * y0[1]) + (y0[2] * y0[2] + y0[3] * y0[3]) + (y1[0] * y1[0] + y1[1] * y1[1]) + (y1[2] * y1[2] + y1[3] * y1[3]);
                    const f32x4 a = y0 * gv[bj][0], b = y1 * gv[bj][1]; u32x4 w; w.x = cvt_pk_bf16(a[0], a[1]); w.y = cvt_pk_bf16(a[2], a[3]); w.z = cvt_pk_bf16(b[0], b[1]); w.w = cvt_pk_bf16(b[2], b[3]);
                    *(u32x4*)px = w; }
                s += __shfl_xor(s, 16); s += __shfl_xor(s, 32);
                if (fq == 0) ss[(size_t)row * 32 + u.pn * 4 + wc] = s;
                asm volatile("" ::: "memory"); }
    }
};
__device__ __forceinline__ void store_nat(const Acc& acc, bf16_t* base, size_t ldc, int row0, int col0, const float* ss) {
#pragma unroll
    for (int ai = 0; ai < 2; ++ai)
#pragma unroll
        for (int m = 0; m < 4; ++m) { const int row = row0 + ai * HALF + m * 16; const float rs = ss ? rstd_of(ss, row) : 1.0f;
#pragma unroll
            for (int bj = 0; bj < 2; ++bj) { const f32x4 a = acc[ai][bj][m][0] * rs, b = acc[ai][bj][m][1] * rs; u32x4 w; w.x = cvt_pk_bf16(a[0], a[1]); w.y = cvt_pk_bf16(a[2], a[3]); w.z = cvt_pk_bf16(b[0], b[1]); w.w = cvt_pk_bf16(b[2], b[3]);
                *(u32x4*)(base + (size_t)row * ldc + col0 + bj * HALF) = w; } }
}
struct EpiWin {
    static constexpr bool AFTER_DRAIN = false;
    bf16_t* P; bf16_t* KT; bf16_t* VT; const float* ss;
    __device__ __forceinline__ void operator()(const Acc& acc, const Unit& u, int wr, int wc, int fr, int fq) const {
        const int row0 = u.pm * BM + wr * 64 + fr;
        if (u.pn < 6 || u.pn >= 12) { store_nat(acc, P, 4096, row0, u.pn * BM + wc * 32 + 8 * fq, ss); return; }
        const bool isk = u.pn < 8;
#pragma unroll
        for (int ai = 0; ai < 2; ++ai) { const int chunk = u.pm * 4 + ai * 2 + wr;
#pragma unroll
            for (int m = 0; m < 4; ++m) { const int row = row0 + ai * HALF + m * 16; const float rs = rstd_of(ss, row); const int i = m * 16 + fr;
#pragma unroll
                for (int bj = 0; bj < 2; ++bj)
#pragma unroll
                    for (int n = 0; n < 2; ++n) { const f32x4 a = acc[ai][bj][m][n] * rs; const int c = bj * HALF + wc * 32 + 8 * fq + 4 * n;
                        bf16_t* dst;
                        if (isk) { const int kf = (u.pn - 6) * 256 + c; dst = KT + ((size_t)(chunk * 4 + (kf >> 7)) * 8192 + (size_t)(kf & 127) * 64 + i); }
                        else { dst = VT + ((size_t)(chunk * 4 + (u.pn - 8)) * 16384 + (size_t)c * 64 + i); }
                        const unsigned p0 = cvt_pk_bf16(a[0], a[1]), p1 = cvt_pk_bf16(a[2], a[3]);
                        dst[0] = (bf16_t)p0; dst[64] = (bf16_t)(p0 >> 16); dst[128] = (bf16_t)p1; dst[192] = (bf16_t)(p1 >> 16); } } }
    }
};
struct EpiMemKV {
    static constexpr bool AFTER_DRAIN = false;
    bf16_t* MK; bf16_t* MV;
    __device__ __forceinline__ void operator()(const Acc& acc, const Unit& u, int wr, int wc, int fr, int fq) const {
        const int h = (u.pn & 7) >> 1, d0 = (u.pn & 1) * 256; bf16_t* base = (u.pn < 8 ? MK : MV) + (size_t)(u.pm * 4 + h) * 256 * 512;
        store_nat(acc, base, 512, wr * 64 + fr, d0 + wc * 32 + 8 * fq, nullptr);
    }
};
struct EpiTile {
    static constexpr bool AFTER_DRAIN = false;
    bf16_t* O; size_t NR;
    __device__ __forceinline__ void operator()(const Acc& acc, const Unit& u, int wr, int wc, int fr, int fq) const {
        bf16_t* base = O + u.o;
#pragma unroll
        for (int ai = 0; ai < 2; ++ai)
#pragma unroll
            for (int m = 0; m < 4; ++m) { const int row = u.r0 + ai * HALF + wr * 64 + m * 16 + fr;
#pragma unroll
                for (int bj = 0; bj < 2; ++bj) { const int col = u.c0 + bj * HALF + wc * 32 + 8 * fq; const f32x4 a = acc[ai][bj][m][0], b = acc[ai][bj][m][1];
                    u32x4 w; w.x = cvt_pk_bf16(a[0], a[1]); w.y = cvt_pk_bf16(a[2], a[3]); w.z = cvt_pk_bf16(b[0], b[1]); w.w = cvt_pk_bf16(b[2], b[3]);
                    *(u32x4*)(base + ((size_t)(col >> 6) * NR + row) * 64 + (col & 63)) = w; } }
    }
};
struct EpiSoftmax {
    static constexpr bool AFTER_DRAIN = true;
    bf16_t* Pout; const float* ss;
    __device__ __forceinline__ void operator()(const Acc&, const Unit&, int, int, int, int) const {}
    __device__ __forceinline__ void fused(Acc& acc, const Unit& u, int wr, int wc, int fr, int fq, LAS unsigned char* lds, int wid, int lane) const {
        LAS float* X = (LAS float*)lds; LAS float* Y = (LAS float*)(lds + 4096);
        const float sc = 0.04419417382f * 1.44269504f;
#pragma unroll
        for (int ai = 0; ai < 2; ++ai)
#pragma unroll
            for (int m = 0; m < 4; ++m) { float mx = -3.0e38f; const float rs = rstd_of(ss, u.pm * BM + ai * HALF + wr * 64 + m * 16 + fr);
#pragma unroll
                for (int bj = 0; bj < 2; ++bj)
#pragma unroll
                    for (int n = 0; n < 2; ++n) { const f32x4 a = acc[ai][bj][m][n] * rs; acc[ai][bj][m][n] = a; mx = fmaxf(mx, fmaxf(fmaxf(a[0], a[1]), fmaxf(a[2], a[3]))); }
                mx = fmaxf(mx, __shfl_xor(mx, 16)); mx = fmaxf(mx, __shfl_xor(mx, 32));
                if (fq == 0) X[(ai * HALF + wr * 64 + m * 16 + fr) * 4 + wc] = mx; }
        asm volatile("s_waitcnt lgkmcnt(0)" ::: "memory"); __builtin_amdgcn_s_barrier(); asm volatile("" ::: "memory");
#pragma unroll
        for (int ai = 0; ai < 2; ++ai)
#pragma unroll
            for (int m = 0; m < 4; ++m) { const int r = ai * HALF + wr * 64 + m * 16 + fr; const f32x4 mv = *(const LAS f32x4*)(X + r * 4);
                const float rm = fmaxf(fmaxf(mv[0], mv[1]), fmaxf(mv[2], mv[3])) * sc; float s = 0.f;
#pragma unroll
                for (int bj = 0; bj < 2; ++bj)
#pragma unroll
                    for (int n = 0; n < 2; ++n) { f32x4 a = acc[ai][bj][m][n];
#pragma unroll
                        for (int j = 0; j < 4; ++j) { a[j] = __builtin_amdgcn_exp2f(a[j] * sc - rm); s += a[j]; }
                        acc[ai][bj][m][n] = a; }
                s += __shfl_xor(s, 16); s += __shfl_xor(s, 32);
                if (fq == 0) Y[r * 4 + wc] = s; }
        asm volatile("s_waitcnt lgkmcnt(0)" ::: "memory"); __builtin_amdgcn_s_barrier(); asm volatile("" ::: "memory");
        const int row0 = u.pm * BM + wr * 64 + fr, col0 = u.z * 256 + wc * 32 + 8 * fq;
#pragma unroll
        for (int ai = 0; ai < 2; ++ai)
#pragma unroll
            for (int m = 0; m < 4; ++m) { const int r = ai * HALF + wr * 64 + m * 16 + fr; const f32x4 sv = *(const LAS f32x4*)(Y + r * 4);
                const float inv = 1.0f / ((sv[0] + sv[1]) + (sv[2] + sv[3])); const int row = row0 + ai * HALF + m * 16;
#pragma unroll
                for (int bj = 0; bj < 2; ++bj) { const f32x4 a = acc[ai][bj][m][0] * inv, b = acc[ai][bj][m][1] * inv; u32x4 w; w.x = cvt_pk_bf16(a[0], a[1]); w.y = cvt_pk_bf16(a[2], a[3]); w.z = cvt_pk_bf16(b[0], b[1]); w.w = cvt_pk_bf16(b[2], b[3]);
                    const int cp = col0 + bj * HALF; *(u32x4*)(Pout + ((size_t)(cp >> 6) * T + row) * 64 + (cp & 63)) = w; } }
    }
};
struct WinFoldOrder {
    int c; const char* PW; const char* WINU;
    __device__ bool next(int i, Unit& u) const { if (i > 0 || c < 0 || c >= 32) return false; const int g = c >> 3; u.pm = g; u.z = 0; u.pn = c & 7;
        u.a = PW + (size_t)g * 65536 * 2; u.b = WINU + ((size_t)u.pn * 256 * 1024 + g * 256) * 2; u.o = 0; u.r0 = g * 256; u.c0 = u.pn * 256; return true; }
};
struct WqKOrder {
    int c; const char* MK; const char* WQN;
    __device__ bool next(int i, Unit& u) const { if (i > 0 || c < 0 || c >= 64) return false; const int b = c >> 5, h = (c >> 3) & 3; u.pm = b; u.z = h; u.pn = c & 7;
        u.a = MK + (size_t)((b * 4 + h) * 256 * 512) * 2; u.b = WQN + ((size_t)u.pn * 256 * D + h * 512) * 2; u.o = (size_t)b * 1024 * D; u.r0 = h * 256; u.c0 = u.pn * 256; return true; }
};
struct VWoOrder {
    int c; const char* WOT; const char* MV;
    __device__ bool next(int i, Unit& u) const { if (i > 0 || c < 0 || c >= 64) return false; const int b = c >> 5, h = (c >> 3) & 3; u.pm = c & 7; u.z = h; u.pn = 0;
        u.a = WOT + ((size_t)u.pm * 256 * D + h * 512) * 2; u.b = MV + (size_t)((b * 4 + h) * 256 * 512) * 2; u.o = (size_t)b * D * 1024; u.r0 = u.pm * 256; u.c0 = h * 256; return true; }
};
struct LogitOrder {
    int c; const char* A; const char* WQK;
    __device__ bool next(int i, Unit& u) const { if (i > 0 || c >= 256) return false; const int v = (c & 7) * 32 + (c >> 3); u.pm = v >> 2; u.z = v & 3; u.pn = 0; u.o = 0;
        u.a = A + (size_t)u.pm * 256 * 64 * 2; u.b = WQK + ((size_t)(u.pm >> 5) * 1024 * D + (size_t)u.z * 256 * 64) * 2; return true; }
};
struct MemKVOrder {
    int c; const char* A; const char* B;
    __device__ bool next(int i, Unit& u) const { if (i > 0 || c >= 32 || c < 0) return false; u.pm = c & 1; u.pn = c >> 1; u.z = 0; u.o = 0; u.a = A + (size_t)u.pm * 256 * D * 2; u.b = B + (size_t)u.pn * 256 * D * 2; return true; }
};
}

struct Params {
    const float *x, *mem, *ffn1_norm, *ffn1_wg, *ffn1_wu, *ffn1_wd, *mix_norm, *w_in, *pool_w, *pool_scale, *gla_w_a2, *gla_b_a, *gla_head_norm, *w_out,
        *xattn_norm, *mem_norm, *wq, *wkv, *wo, *ffn2_norm, *ffn2_wg, *ffn2_wu, *ffn2_wd, *final_norm;
    float* out; unsigned char* ws;
};

__device__ __forceinline__ float wave_sum(float v) {
#pragma unroll
    for (int o = 1; o < 64; o <<= 1) v += __shfl_xor(v, o);
    return v;
}

__device__ __forceinline__ void conv_item(const float* W, int K, int ld, int nblk, bf16_t* WT, int mode, LAS float* scr, int item, int lane, int tiledNR = 0) {
    const int kb = item / nblk, nb = item - kb * nblk, k0 = 64 * kb, n0 = 64 * nb;
    const float* src = W + (size_t)k0 * ld + n0 + lane;
    float tv[64];
#pragma unroll
    for (int kk = 0; kk < 64; ++kk) tv[kk] = __builtin_nontemporal_load(src + (size_t)kk * ld);
#pragma unroll
    for (int kk = 0; kk < 64; ++kk) scr[kk * 65 + lane] = tv[kk];
    asm volatile("s_waitcnt lgkmcnt(0)" ::: "memory");
    const int c = lane & 7;
    const int rbase = (mode == 0) ? n0 : ((n0 >> 7) * 256 + (n0 & 127) + (mode == 2 ? 128 : 0));
#pragma unroll
    for (int j = 0; j < 8; ++j) { const int n = (lane >> 3) + 8 * j; const LAS float* s = scr + (8 * c) * 65 + n;
        u32x4 o; o.x = cvt_pk_bf16(s[0], s[65]); o.y = cvt_pk_bf16(s[2 * 65], s[3 * 65]); o.z = cvt_pk_bf16(s[4 * 65], s[5 * 65]); o.w = cvt_pk_bf16(s[6 * 65], s[7 * 65]);
        if (tiledNR) *(u32x4*)(WT + ((size_t)(k0 >> 6) * tiledNR + rbase + n) * 64 + 8 * c) = o; else *(u32x4*)(WT + (size_t)(rbase + n) * K + k0 + 8 * c) = o; }
    asm volatile("s_waitcnt lgkmcnt(0)" ::: "memory");
}
template <bool TILED>
__device__ __forceinline__ void rms_row_to_bf16(const float* xrow, const float* gain, bf16_t* obase, int m, int lane, float* rsout = nullptr) {
    f32x4 v[8]; float s = 0.f;
#pragma unroll
    for (int j = 0; j < 8; ++j) { v[j] = *(const f32x4*)(xrow + 4 * lane + 256 * j); s += (v[j][0] * v[j][0] + v[j][1] * v[j][1]) + (v[j][2] * v[j][2] + v[j][3] * v[j][3]); }
    const float rs = rsqrtf(wave_sum(s) * (1.0f / 2048.0f) + EPS);
    if (rsout && lane == 0) rsout[m] = rs;
#pragma unroll
    for (int j = 0; j < 8; ++j) { const f32x4 g = *(const f32x4*)(gain + 4 * lane + 256 * j); const f32x4 y = v[j] * g * rs; u32x2 w; w.x = cvt_pk_bf16(y[0], y[1]); w.y = cvt_pk_bf16(y[2], y[3]);
        const int c = 4 * lane + 256 * j;
        if (TILED) *(u32x2*)(obase + ((size_t)(c >> 6) * T + m) * 64 + (c & 63)) = w; else *(u32x2*)(obase + (size_t)m * D + c) = w; }
}

template <int W>
__device__ __forceinline__ void pool_elem(const bf16_t* PN, const float* pscale, bf16_t* MIX, int tA, int tB, bool hasB, int c) {
    const int tt[2] = {tA, hasB ? tB : tA};
    u32x4 cj[2][W]; int cnt[2];
#pragma unroll
    for (int q = 0; q < 2; ++q) { const int spos = tt[q] & (SEQ - 1); cnt[q] = (spos + 1 < W) ? spos + 1 : W; const char* up = (const char*)(PN + (size_t)tt[q] * 4096 + c);
#pragma unroll
        for (int j = 0; j < W; ++j) { const unsigned jj = (j < cnt[q]) ? (unsigned)j : 0u; cj[q][j] = *(const u32x4*)(up - jj * 8192u); } }
    const f32x4 p0 = *(const f32x4*)(pscale + c), p1 = *(const f32x4*)(pscale + c + 4);
#pragma unroll
    for (int q = 0; q < 2; ++q) { const float inv = 1.0f / (float)cnt[q];
        float s[8] = {0.f, 0.f, 0.f, 0.f, 0.f, 0.f, 0.f, 0.f};
#pragma unroll
        for (int j = 0; j < W; ++j) { const float m = (j < cnt[q]) ? 1.0f : 0.0f; const u32x4 v = cj[q][j];
            s[0] += m * bf_lo(v.x); s[1] += m * bf_hi(v.x); s[2] += m * bf_lo(v.y); s[3] += m * bf_hi(v.y);
            s[4] += m * bf_lo(v.z); s[5] += m * bf_hi(v.z); s[6] += m * bf_lo(v.w); s[7] += m * bf_hi(v.w); }
        const u32x4 z0 = cj[q][0];
        u32x4 w; w.x = cvt_pk_bf16((s[0] * inv - bf_lo(z0.x)) * p0[0], (s[1] * inv - bf_hi(z0.x)) * p0[1]); w.y = cvt_pk_bf16((s[2] * inv - bf_lo(z0.y)) * p0[2], (s[3] * inv - bf_hi(z0.y)) * p0[3]);
        w.z = cvt_pk_bf16((s[4] * inv - bf_lo(z0.z)) * p1[0], (s[5] * inv - bf_hi(z0.z)) * p1[1]); w.w = cvt_pk_bf16((s[6] * inv - bf_lo(z0.w)) * p1[2], (s[7] * inv - bf_hi(z0.w)) * p1[3]);
        if (q == 0 || hasB) *(u32x4*)(MIX + ((size_t)(c >> 6) * T + tt[q]) * 64 + (c & 63)) = w; }
}

#define XB_TMO      128
#define XB_XCNT(j)  (256  + 64 * (j))
#define XB_XSUB(j)  (1280 + 64 * (j))
#define XB_XGEN(j)  (2304 + 64 * (j))
#define XB_TOP      3328
#define XB_TOPGEN   3392
#define XCD_BAR_WORDS 3456
#define XB_SPIN_CAP (1u << 18)

__device__ __forceinline__ unsigned xb_ld(unsigned* p)              { return __hip_atomic_load(p, __ATOMIC_RELAXED, __HIP_MEMORY_SCOPE_AGENT); }
__device__ __forceinline__ unsigned xb_add(unsigned* p, unsigned v) { return __hip_atomic_fetch_add(p, v, __ATOMIC_RELAXED, __HIP_MEMORY_SCOPE_AGENT); }
__device__ __forceinline__ unsigned xb_xcc_id() { return (unsigned)__builtin_amdgcn_s_getreg((3 << 11) | 20) & 0xFu; }
#define XB_SPIN(cond, bar) do { unsigned _sp = 0; while (cond) { __builtin_amdgcn_s_sleep(1); \
    if ((++_sp & 255u) == 0u) { if (xb_ld(&(bar)[XB_TMO])) break; if (_sp > XB_SPIN_CAP) { atomicAdd(&(bar)[XB_TMO], 1u); break; } } } } while (0)

struct XcdBarrier {
    unsigned* bar; unsigned x;
    volatile LAS unsigned* st;
};

__device__ __forceinline__ XcdBarrier xcd_barrier_post(unsigned* bar, volatile LAS unsigned* st) {
    XcdBarrier b; b.bar = bar; b.x = xb_xcc_id(); b.st = st;
    if (threadIdx.x == 0) (void)xb_add(&bar[XB_XCNT(b.x)], 1u);
    return b;
}
__device__ __forceinline__ void xcd_barrier_complete(unsigned* bar, unsigned x, unsigned& nloc, unsigned& nx) {
    const unsigned G = gridDim.x * gridDim.y * gridDim.z;
    unsigned sum, cnt, mine, sp = 0u;
    for (;;) {
        sum = 0u; cnt = 0u; mine = 0u;
#pragma unroll
        for (unsigned j = 0; j < 16; ++j) { const unsigned c = xb_ld(&bar[XB_XCNT(j)]); sum += c; cnt += (c > 0u) ? 1u : 0u; mine = (j == x) ? c : mine; }
        if (sum == G) break;
        __builtin_amdgcn_s_sleep(1);
        if ((++sp & 255u) == 0u) { if (xb_ld(&bar[XB_TMO])) break; if (sp > XB_SPIN_CAP) { atomicAdd(&bar[XB_TMO], 1u); break; } }
    }
    nloc = mine > 0u ? mine : 1u; nx = cnt > 0u ? cnt : 1u;
}

__device__ __forceinline__ void xcd_barrier(const XcdBarrier& b) {
    asm volatile("s_waitcnt vmcnt(0)" ::: "memory");
    __syncthreads();
    if (threadIdx.x == 0) {
        unsigned* bar = b.bar;
        __builtin_amdgcn_s_waitcnt(0);
        unsigned nloc = b.st[0], nx = b.st[1];
        if (nloc == 0u) { xcd_barrier_complete(bar, b.x, nloc, nx); b.st[0] = nloc; b.st[1] = nx; }
        const unsigned old = xb_add(&bar[XB_XSUB(b.x)], 1u);
        const unsigned gen = old / nloc;
        if (old + 1u == (gen + 1u) * nloc) {
            __builtin_amdgcn_fence(__ATOMIC_RELEASE, "agent");
            asm volatile("s_waitcnt vmcnt(0)" ::: "memory");
            const unsigned og = xb_add(&bar[XB_TOP], 1u);
            const unsigned tg = og / nx;
            if (og + 1u == (tg + 1u) * nx) xb_add(&bar[XB_TOPGEN], 1u);
            else XB_SPIN(xb_ld(&bar[XB_TOPGEN]) == tg, bar);
            __builtin_amdgcn_fence(__ATOMIC_ACQUIRE, "agent");
            xb_add(&bar[XB_XGEN(b.x)], 1u);
            asm volatile("s_waitcnt vmcnt(0)" ::: "memory");
        } else {
            XB_SPIN(xb_ld(&bar[XB_XGEN(b.x)]) == gen, bar);
            __builtin_amdgcn_fence(__ATOMIC_ACQUIRE, "agent");
            asm volatile("s_waitcnt vmcnt(0)" ::: "memory");
        }
    }
    __syncthreads();
}

#define GRID_SYNC() xcd_barrier(xbar)
__global__ void __launch_bounds__(NTHR, 2) fwd_megakernel(Params p) {
    extern __shared__ __attribute__((aligned(16))) unsigned char lds_raw[];
    LAS unsigned char* lds = (LAS unsigned char*)lds_raw;
    cg::grid_group grid = cg::this_grid();
    const int tid = threadIdx.x, lane = tid & 63, wave = __builtin_amdgcn_readfirstlane(tid >> 6), fr = lane & 15, fq = lane >> 4;
    const int bx = blockIdx.x, G = gridDim.x;
    const int gw = bx * 8 + wave, NGW = G * 8;
    const size_t gtid = (size_t)bx * NTHR + tid, NGT = (size_t)G * NTHR;
    unsigned char* ws = p.ws;
    volatile LAS unsigned* xst = (volatile LAS unsigned*)(lds + 133120);
    if (tid < 2) xst[tid] = 0u;
    __syncthreads();
    XcdBarrier xbar = xcd_barrier_post((unsigned*)(ws + WS_BAR), xst);
    if (p.ws == nullptr) grid.sync();
    float* SS = (float*)(ws + WS_SS); float* ALR = (float*)(ws + WS_ALR); float* BEND = (float*)(ws + WS_BEND);
    bf16_t* MEMH = (bf16_t*)(ws + WS_MEMH); bf16_t* MEMK = (bf16_t*)(ws + WS_MEMK); bf16_t* MEMVT = (bf16_t*)(ws + WS_MEMVT);
    bf16_t* W1GU = (bf16_t*)(ws + WS_W1GU); bf16_t* W1D = (bf16_t*)(ws + WS_W1D); bf16_t* W2GU = (bf16_t*)(ws + WS_W2GU); bf16_t* W2D = (bf16_t*)(ws + WS_W2D);
    bf16_t* WIN = (bf16_t*)(ws + WS_WIN); bf16_t* WA = (bf16_t*)(ws + WS_WA); bf16_t* POOLW = (bf16_t*)(ws + WS_POOLW); bf16_t* WOUT = (bf16_t*)(ws + WS_WOUT);
    bf16_t* WQ = (bf16_t*)(ws + WS_WQ); bf16_t* WKV = (bf16_t*)(ws + WS_WKV); bf16_t* WO = (bf16_t*)(ws + WS_WO);
    bf16_t* H = (bf16_t*)(ws + WS_H); bf16_t* ACT = (bf16_t*)(ws + WS_ACT); bf16_t* MIX = (bf16_t*)(ws + WS_MIX);
    bf16_t* PN = ACT; bf16_t* KT = (bf16_t*)(ws + WS_ACT + ACT_KT); bf16_t* VT = (bf16_t*)(ws + WS_ACT + ACT_VT);
    bf16_t* PATT = (bf16_t*)(ws + WS_ACT + ACT_PATT); bf16_t* WQK = (bf16_t*)(ws + WS_ACT + ACT_WQK); bf16_t* VWOT = (bf16_t*)(ws + WS_ACT + ACT_VWOT);
    bf16_t* KV = (bf16_t*)p.out;
    float* RS0 = (float*)(ws + WS_RS0);

    {
        LAS float* scr = (LAS float*)(lds + wave * 16640);
        constexpr int I_FF = (D / 64) * (FF / 64);
        constexpr int I_IN = (D / 64) * (4096 / 64);
        constexpr int I_DD = (D / 64) * (D / 64);
        constexpr int I_INR = (D / 64) * (3072 / 64);
        constexpr int NITEMS = 6 * I_FF + I_INR + 64 + I_DD * 2 + I_IN;
        for (int it = gw; it < NITEMS; it += NGW) {
            int r = it;
            if (r < I_FF) { conv_item(p.ffn1_wg, D, FF, FF / 64, W1GU, 1, scr, r, lane, 2 * FF); continue; } r -= I_FF;
            if (r < I_FF) { conv_item(p.ffn1_wu, D, FF, FF / 64, W1GU, 2, scr, r, lane, 2 * FF); continue; } r -= I_FF;
            if (r < I_FF) { conv_item(p.ffn1_wd, FF, D, D / 64, W1D, 0, scr, r, lane, D); continue; } r -= I_FF;
            if (r < I_FF) { conv_item(p.ffn2_wg, D, FF, FF / 64, W2GU, 1, scr, r, lane, 2 * FF); continue; } r -= I_FF;
            if (r < I_FF) { conv_item(p.ffn2_wu, D, FF, FF / 64, W2GU, 2, scr, r, lane, 2 * FF); continue; } r -= I_FF;
            if (r < I_FF) { conv_item(p.ffn2_wd, FF, D, D / 64, W2D, 0, scr, r, lane, D); continue; } r -= I_FF;
            if (r < I_INR) { conv_item(p.w_in + 1024, D, 4112, 3072 / 64, WIN + (size_t)1024 * 64, 0, scr, r, lane, 4096); continue; } r -= I_INR;
            if (r < 64) { const int g = r >> 4; conv_item(p.pool_w + (size_t)g * 65536, 256, 256, 4, POOLW + (size_t)g * 65536, 0, scr, r & 15, lane); continue; } r -= 64;
            if (r < I_DD) { conv_item(p.w_out, D, D, D / 64, WOUT, 0, scr, r, lane, D); continue; } r -= I_DD;
            if (r < I_DD) { conv_item(p.wo, D, D, D / 64, WO, 0, scr, r, lane); continue; } r -= I_DD;
            conv_item(p.wkv, D, 4096, 4096 / 64, WKV, 0, scr, r, lane);
        }
        for (size_t i = gtid; i < (size_t)D * D / 8; i += NGT) { const f32x4 a = ((const f32x4*)p.wq)[2 * i], b = ((const f32x4*)p.wq)[2 * i + 1];
            u32x4 w; w.x = cvt_pk_bf16(a[0], a[1]); w.y = cvt_pk_bf16(a[2], a[3]); w.z = cvt_pk_bf16(b[0], b[1]); w.w = cvt_pk_bf16(b[2], b[3]); ((u32x4*)WQ)[i] = w; }
        for (size_t i = gtid; i < (size_t)D * 1024 / 8; i += NGT) { const size_t kd = i >> 7, c = (i & 127) * 8; const float* src = p.w_in + kd * 4112 + c;
            const f32x4 a = *(const f32x4*)src, b = *(const f32x4*)(src + 4);
            u32x4 w; w.x = cvt_pk_bf16(a[0], a[1]); w.y = cvt_pk_bf16(a[2], a[3]); w.z = cvt_pk_bf16(b[0], b[1]); w.w = cvt_pk_bf16(b[2], b[3]); ((u32x4*)MIX)[i] = w; }
        for (size_t i = gtid; i < 32768; i += NGT) { const int k = (int)(i >> 4), r = (int)(i & 15); WA[r * D + k] = (bf16_t)cvt_pk_bf16(p.w_in[(size_t)k * 4112 + 4096 + r], 0.f); }
        for (int m = gw; m < T + MEMT; m += NGW) {
            if (m < T) rms_row_to_bf16<true>(p.x + (size_t)m * D, p.ffn1_norm, H, m, lane, RS0);
            else rms_row_to_bf16<false>(p.mem + (size_t)(m - T) * D, p.mem_norm, MEMH, m - T, lane);
        }
    }
    GRID_SYNC();
    { pg8::StdOrder S; S.init(T, 2 * FF, G, bx, H, 64, W1GU, 64); pg8::EpiSwiglu E{ACT, nullptr}; pg8::gemm_phase<true>(lds, 64, 64, D, S, E, (size_t)T * 64 * 2, (size_t)2 * FF * 64 * 2); }
    GRID_SYNC();
    { pg8::StdOrder S; S.init(T, D, G, bx, ACT, 64, W1D, 64); S.wgm = 4; pg8::EpiResid E{H, p.ffn1_norm, RS0, p.mix_norm, SS, 0.5f}; pg8::gemm_phase<true>(lds, 64, 64, FF, S, E, (size_t)T * 64 * 2, (size_t)D * 64 * 2); }
    { pg8::WinFoldOrder S{bx, (const char*)POOLW, (const char*)MIX}; pg8::EpiTile E{WIN, (size_t)4096}; pg8::gemm_phase<true>(lds, 256, 1024, 256, S, E); }
    GRID_SYNC();
    {
        { pg8::StdOrder S; S.init(T, 4096, G, bx, H, 64, WIN, 64); pg8::EpiWin E{PN, KT, VT, SS}; pg8::gemm_phase<true>(lds, 64, 64, D, S, E, (size_t)T * 64 * 2, (size_t)4096 * 64 * 2); }
        {
            const int tb = wave & 3, kh = wave >> 2; const int tok = bx * 64 + tb * 16 + fr;
            const bf16_t* ap = H + ((size_t)(kh * 16) * T + tok) * 64 + fq * 8; const bf16_t* wp = WA + (size_t)fr * D + kh * 1024 + fq * 8;
            f32x4 acc = {0.f, 0.f, 0.f, 0.f};
#pragma unroll 8
            for (int ks = 0; ks < 32; ++ks) { const bf16x8 wf = *(const bf16x8*)(wp + ks * 32), af = *(const bf16x8*)(ap + (size_t)(ks >> 1) * T * 64 + (ks & 1) * 32); acc = __builtin_amdgcn_mfma_f32_16x16x32_bf16(wf, af, acc, 0, 0, 0); }
            LAS f32x4* ex = (LAS f32x4*)lds;
            if (kh == 1) ex[tb * 64 + lane] = acc;
            __syncthreads();
            if (kh == 0) { const f32x4 o = (acc + ex[tb * 64 + lane]) * rstd_of(SS, tok); *(f32x4*)(ALR + (size_t)tok * 16 + 4 * fq) = o; }
        }
    }
    GRID_SYNC();
    constexpr int GA = 224;
    if (bx >= GA) { pg8::MemKVOrder S{bx - GA, (const char*)MEMH, (const char*)WKV}; pg8::EpiMemKV E{MEMK, MEMVT}; pg8::gemm_phase<true>(lds, D, D, D, S, E); }
    else {
        LAS float* alr_s = (LAS float*)lds; LAS float* w2_s = (LAS float*)(lds + 4096); LAS float* ba_s = (LAS float*)(lds + 12288); LAS float* gsum = (LAS float*)(lds + 12800);
        LAS bf16_t* KD = (LAS bf16_t*)(lds + 16384);
        {
            const int h = bx & 3; const int k = tid & 127, fg = tid >> 7;
            { const int idx = tid * 4, r = idx >> 7, kk = idx & 127; *(LAS f32x4*)(w2_s + idx) = *(const f32x4*)(p.gla_w_a2 + r * 512 + h * 128 + kk); }
            const float bk = p.gla_b_a[h * 128 + k];
            __syncthreads();
            float w[16];
#pragma unroll
            for (int r = 0; r < 16; ++r) w[r] = w2_s[r * 128 + k];
            f32x4 n_alr = {0.f, 0.f, 0.f, 0.f}; u32x4 n_k0, n_k1; bf16x8 n_vf[2][2];
#define GLA_A_PREFETCH(uu) do { if (tid < 256) n_alr = ((const f32x4*)(ALR + (size_t)((uu) >> 2) * 64 * 16))[tid]; \
                { const u32x4* kp_ = (const u32x4*)(KT + (size_t)(uu) * 8192 + (size_t)k * 64 + fg * 16); n_k0 = kp_[0]; n_k1 = kp_[1]; } \
                _Pragma("unroll") for (int vv = 0; vv < 2; ++vv) _Pragma("unroll") for (int ks = 0; ks < 2; ++ks) \
                    n_vf[vv][ks] = *(const bf16x8*)(VT + (size_t)(uu) * 16384 + (size_t)((2 * wave + vv) * 16 + fr) * 64 + ks * 32 + fq * 8); } while (0)
            GLA_A_PREFETCH(bx);
            for (int u = bx; u < 1024; u += GA) {
                const f32x4 c_alr = n_alr; const u32x4 k0 = n_k0, k1 = n_k1; bf16x8 vf[2][2];
#pragma unroll
                for (int vv = 0; vv < 2; ++vv)
#pragma unroll
                    for (int ks = 0; ks < 2; ++ks) vf[vv][ks] = n_vf[vv][ks];
                if (u + GA < 1024) GLA_A_PREFETCH(u + GA);
                if (tid < 256) ((LAS f32x4*)alr_s)[tid] = c_alr;
                __syncthreads();
                float cum[16]; float run = 0.f;
#pragma unroll
                for (int ii = 0; ii < 16; ++ii) { const int i = fg * 16 + ii; float z = bk;
#pragma unroll
                    for (int r = 0; r < 16; ++r) z += alr_s[i * 16 + r] * w[r];
                    const float la = -(fmaxf(-z, 0.f) + __logf(1.0f + __expf(-fabsf(z)))) * (1.0f / 16.0f);
                    run += la; cum[ii] = run; }
                gsum[fg * 128 + k] = run;
                __syncthreads();
                float prefix = 0.f, total = 0.f;
#pragma unroll
                for (int f = 0; f < 4; ++f) { const float gsv = gsum[f * 128 + k]; total += gsv; if (f < fg) prefix += gsv; }
                if (fg == 0) BEND[(size_t)u * 128 + k] = total;
                { const unsigned kw[8] = {k0.x, k0.y, k0.z, k0.w, k1.x, k1.y, k1.z, k1.w}; unsigned ow[8];
#pragma unroll
                  for (int q = 0; q < 8; ++q) { const float d0 = __expf(total - (cum[2 * q] + prefix)), d1 = __expf(total - (cum[2 * q + 1] + prefix)); ow[q] = cvt_pk_bf16(bf_lo(kw[q]) * d0, bf_hi(kw[q]) * d1); }
                  LAS u32x4* dst = (LAS u32x4*)(KD + k * 72 + fg * 16); dst[0] = (u32x4){ow[0], ow[1], ow[2], ow[3]}; dst[1] = (u32x4){ow[4], ow[5], ow[6], ow[7]}; }
                __syncthreads();
#pragma unroll
                for (int kp = 0; kp < 4; ++kp) { u32x2 w0[2], w1[2];
#pragma unroll
                    for (int kq = 0; kq < 2; ++kq) { const int kb = 2 * kp + kq; f32x4 a0 = {0.f, 0.f, 0.f, 0.f}, a1 = {0.f, 0.f, 0.f, 0.f};
#pragma unroll
                        for (int ks = 0; ks < 2; ++ks) { const bf16x8 kf = *(const LAS bf16x8*)(KD + (kb * 16 + fr) * 72 + ks * 32 + fq * 8);
                            a0 = __builtin_amdgcn_mfma_f32_16x16x32_bf16(kf, vf[0][ks], a0, 0, 0, 0); a1 = __builtin_amdgcn_mfma_f32_16x16x32_bf16(kf, vf[1][ks], a1, 0, 0, 0); }
                        w0[kq].x = cvt_pk_bf16(a0[0], a0[1]); w0[kq].y = cvt_pk_bf16(a0[2], a0[3]); w1[kq].x = cvt_pk_bf16(a1[0], a1[1]); w1[kq].y = cvt_pk_bf16(a1[2], a1[3]); }
                    const int eo = kp * 32 + (fq & 1) * 16 + (fq >> 1) * 8;
                    *(u32x4*)(KV + (size_t)u * 32768 + (size_t)((2 * wave) * 16 + fr) * 128 + eo) = pair16(w0[0], w0[1]);
                    *(u32x4*)(KV + (size_t)u * 32768 + (size_t)((2 * wave + 1) * 16 + fr) * 128 + eo) = pair16(w1[0], w1[1]); }
                __syncthreads();
            }
#undef GLA_A_PREFETCH
        }
        { const int gwp = bx * 8 + wave; constexpr int NWP = GA * 8;
          for (int g = 0; g < 4; ++g)
            for (int tp = gwp; tp < 8192; tp += 2 * NWP) { const int tpB = tp + NWP; const bool hasB = tpB < 8192;
                const int tA = 2 * tp + (lane >> 5), tB = 2 * tpB + (lane >> 5), c = g * 256 + (lane & 31) * 8;
                if (g == 0) pool_elem<2>(PN, p.pool_scale, MIX, tA, tB, hasB, c);
                else if (g == 1) pool_elem<4>(PN, p.pool_scale, MIX, tA, tB, hasB, c);
                else if (g == 2) pool_elem<8>(PN, p.pool_scale, MIX, tA, tB, hasB, c);
                else pool_elem<16>(PN, p.pool_scale, MIX, tA, tB, hasB, c); } }
    }
    GRID_SYNC();
    {
        int t5 = threadIdx.x; asm volatile("" : "+v"(t5));
        if (bx < 128) {
            const int e = bx * NTHR + t5; const int bh = e >> 13, qd = e & 8191; const int b = bh >> 2, h = bh & 3; const int k = 4 * (qd & 31);
            f32x4 st = {0.f, 0.f, 0.f, 0.f};
            for (int c0 = 0; c0 < 128; c0 += 16) {
                u32x2 kvw[16]; f32x4 gm[16];
#pragma unroll
                for (int q = 0; q < 16; ++q) { const size_t u = (size_t)((b * 128 + c0 + q) * 4 + h); kvw[q] = *(const u32x2*)(KV + u * 32768 + 4 * qd); gm[q] = *(const f32x4*)(BEND + u * 128 + k); }
#pragma unroll
                for (int q = 0; q < 16; ++q) { const size_t u = (size_t)((b * 128 + c0 + q) * 4 + h);
                    st[0] = __expf(gm[q][0]) * st[0] + bf_lo(kvw[q].x); st[1] = __expf(gm[q][1]) * st[1] + bf_hi(kvw[q].x);
                    st[2] = __expf(gm[q][2]) * st[2] + bf_lo(kvw[q].y); st[3] = __expf(gm[q][3]) * st[3] + bf_hi(kvw[q].y);
                    u32x2 o; o.x = cvt_pk_bf16(st[0], st[1]); o.y = cvt_pk_bf16(st[2], st[3]);
                    *(u32x2*)(KV + u * 32768 + 4 * qd) = o; }
            }
        }
        { pg8::WqKOrder S{bx - 128, (const char*)MEMK, (const char*)WQ}; pg8::EpiTile E{WQK, (size_t)1024}; pg8::gemm_phase<true>(lds, 512, D, 512, S, E); }
        { pg8::VWoOrder S{bx - 192, (const char*)WO, (const char*)MEMVT}; pg8::EpiTile E{VWOT, (size_t)D}; pg8::gemm_phase<true>(lds, D, 512, 512, S, E); }
    }
    GRID_SYNC();
    {
        LAS float* exch = (LAS float*)lds;
        f32x4 hn[8];
#pragma unroll
        for (int vb = 0; vb < 8; ++vb) hn[vb] = *(const f32x4*)(p.gla_head_norm + (bx & 3) * 256 + (wave >> 2) * 128 + vb * 16 + 4 * fq);
        for (int u = bx; u < 1024; u += G) {
            const int h = u & 3, chunk = u >> 2; const int t0 = chunk * 64; const int tb = wave & 3, vh = wave >> 2; const int t = t0 + tb * 16 + fr;
            u32x2 gt[8];
#pragma unroll
            for (int vb = 0; vb < 8; ++vb) gt[vb] = *(const u32x2*)(PN + (size_t)t * 4096 + 3072 + h * 256 + vh * 128 + vb * 16 + 4 * fq);
            bf16x8 qf[4];
#pragma unroll
            for (int ks = 0; ks < 4; ++ks) qf[ks] = *(const bf16x8*)(PN + (size_t)t * 4096 + 1024 + h * 128 + ks * 32 + fq * 8);
            f32x4 acc[8]; float ssq = 0.f;
#pragma unroll
            for (int vb = 0; vb < 8; ++vb) { f32x4 a = {0.f, 0.f, 0.f, 0.f};
#pragma unroll
                for (int ks = 0; ks < 4; ++ks) { const bf16x8 sf = *(const bf16x8*)(KV + (size_t)u * 32768 + (size_t)((vh * 8 + vb) * 16 + fr) * 128 + ks * 32 + fq * 8); a = __builtin_amdgcn_mfma_f32_16x16x32_bf16(sf, qf[ks], a, 0, 0, 0); }
                a = a * 0.08838834764f; acc[vb] = a; ssq += (a[0] * a[0] + a[1] * a[1]) + (a[2] * a[2] + a[3] * a[3]); }
            ssq += __shfl_xor(ssq, 16); ssq += __shfl_xor(ssq, 32);
            if (fq == 0) exch[(vh * 4 + tb) * 16 + fr] = ssq;
            __syncthreads();
            const float tot = exch[tb * 16 + fr] + exch[(4 + tb) * 16 + fr]; const float rs = rsqrtf(tot * (1.0f / 256.0f) + EPS);
#pragma unroll
            for (int vp = 0; vp < 4; ++vp) { u32x2 w2[2];
#pragma unroll
                for (int vq = 0; vq < 2; ++vq) { const int vb = 2 * vp + vq; const u32x2 gw2 = gt[vb];
                    const f32x4 o = acc[vb] * rs * hn[vb]; w2[vq].x = cvt_pk_bf16(o[0] * silu_f(bf_lo(gw2.x)), o[1] * silu_f(bf_hi(gw2.x))); w2[vq].y = cvt_pk_bf16(o[2] * silu_f(bf_lo(gw2.y)), o[3] * silu_f(bf_hi(gw2.y))); }
                const int cm = 1024 + h * 256 + vh * 128 + vp * 32 + (fq & 1) * 16 + (fq >> 1) * 8;
                *(u32x4*)(MIX + ((size_t)(cm >> 6) * T + t) * 64 + (cm & 63)) = pair16(w2[0], w2[1]); }
            __syncthreads();
        }
    }
    GRID_SYNC();
    { pg8::StdOrder S; S.init(T, D, G, bx, MIX, 64, WOUT, 64); pg8::EpiResid E{H, p.mix_norm, nullptr, p.xattn_norm, SS + 32 * T, 1.0f}; pg8::gemm_phase<true>(lds, 64, 64, D, S, E, (size_t)T * 64 * 2, (size_t)D * 64 * 2); }
    GRID_SYNC();
    { pg8::LogitOrder S{bx, (const char*)H, (const char*)WQK}; pg8::EpiSoftmax E{PATT, SS + 32 * T}; pg8::gemm_phase<false>(lds, 64, 64, D, S, E, (size_t)T * 64 * 2, (size_t)1024 * 64 * 2); }
    GRID_SYNC();
    { pg8::StdOrder S; S.init(T, D, G, bx, PATT, 64, VWOT, 64); S.bbatch = (size_t)D * 1024 * 2; pg8::EpiResid E{H, p.xattn_norm, nullptr, p.ffn2_norm, SS + 64 * T, 1.0f}; pg8::gemm_phase<true>(lds, 64, 64, 1024, S, E, (size_t)T * 64 * 2, (size_t)D * 64 * 2); }
    GRID_SYNC();
    { pg8::StdOrder S; S.init(T, 2 * FF, G, bx, H, 64, W2GU, 64); pg8::EpiSwiglu E{ACT, SS + 64 * T}; pg8::gemm_phase<true>(lds, 64, 64, D, S, E, (size_t)T * 64 * 2, (size_t)2 * FF * 64 * 2); }
    GRID_SYNC();
    { pg8::StdOrder S; S.init(T, D, G, bx, ACT, 64, W2D, 64); S.wgm = 4; pg8::EpiResid E{H, p.ffn2_norm, nullptr, p.final_norm, SS + 96 * T, 0.5f};   pg8::gemm_phase<true>(lds, 64, 64, FF, S, E, (size_t)T * 64 * 2, (size_t)D * 64 * 2); }
    GRID_SYNC();
    { int t14 = threadIdx.x; asm volatile("" : "+v"(t14)); const int l14 = t14 & 63, gw14 = blockIdx.x * 8 + (t14 >> 6);
      const float* ss3 = SS + 96 * T;
      for (int m = gw14; m < T; m += NGW) {
          const float part = (l14 < 32) ? ss3[(size_t)m * 32 + l14] : 0.f; const float rs = rsqrtf(wave_sum(part) * (1.0f / 2048.0f) + EPS);
#pragma unroll
          for (int j4 = 0; j4 < 4; ++j4) { const int col = (l14 + 64 * j4) * 8; const u32x4 w = *(const u32x4*)(H + ((size_t)(col >> 6) * T + m) * 64 + (col & 63));
              f32x4 a, b; a[0] = bf_lo(w.x) * rs; a[1] = bf_hi(w.x) * rs; a[2] = bf_lo(w.y) * rs; a[3] = bf_hi(w.y) * rs; b[0] = bf_lo(w.z) * rs; b[1] = bf_hi(w.z) * rs; b[2] = bf_lo(w.w) * rs; b[3] = bf_hi(w.w) * rs;
              *(f32x4*)(p.out + (size_t)m * D + col) = a; *(f32x4*)(p.out + (size_t)m * D + col + 4) = b; } } }
}

extern "C" void kernel_launch(void* const* d_in, const int* in_sizes, int n_in, void* d_out, int out_size, void* d_ws, size_t ws_size, hipStream_t stream) {
    static int grid = 0;
    if (grid == 0) {
        if (n_in != 24 || out_size != T * D || ws_size < WS_END) { fprintf(stderr, "kernel_launch: unexpected shapes n_in %d out %d ws %zu (need %zu)\n", n_in, out_size, ws_size, (size_t)WS_END); grid = -1; return; }
        int dev = 0, cus = 0, per_cu = 0;
        (void)hipGetDevice(&dev); (void)hipDeviceGetAttribute(&cus, hipDeviceAttributeMultiprocessorCount, dev);
        (void)hipFuncSetAttribute((const void*)fwd_megakernel, hipFuncAttributeMaxDynamicSharedMemorySize, LDS_BYTES);
        (void)hipOccupancyMaxActiveBlocksPerMultiprocessor(&per_cu, (const void*)fwd_megakernel, NTHR, LDS_BYTES);
        (void)hipGetLastError();
        grid = cus < NWG ? cus : NWG;
        if (per_cu < 1) fprintf(stderr, "kernel_launch: occupancy query says %d blocks/CU\n", per_cu);
    }
    if (grid < 0) return;
    if (hipMemsetAsync((char*)d_ws + WS_BAR, 0, 16384, stream) != hipSuccess) { fprintf(stderr, "kernel_launch: memset failed\n"); return; }
    Params p{};
    const float** pp = (const float**)&p;
    for (int i = 0; i < 24; ++i) pp[i] = (const float*)d_in[i];
    p.out = (float*)d_out; p.ws = (unsigned char*)d_ws;
    void* args[] = {&p};
    hipError_t e = hipLaunchCooperativeKernel((const void*)fwd_megakernel, dim3(grid), dim3(NTHR), args, LDS_BYTES, stream);
    if (e != hipSuccess) fprintf(stderr, "cooperative launch failed: %s (grid %d)\n", hipGetErrorString(e), grid);
}
```

```cpp
#include <hip/hip_runtime.h>
#include <hip/hip_cooperative_groups.h>
#include <cstdio>
#include <cstdint>
namespace cg = cooperative_groups;

#define LAS __attribute__((address_space(3)))
typedef unsigned short bf16_t;
typedef short bf16x8 __attribute__((ext_vector_type(8)));
typedef float f32x4 __attribute__((ext_vector_type(4)));
typedef float f32x2 __attribute__((ext_vector_type(2)));
typedef unsigned u32x4 __attribute__((ext_vector_type(4)));
typedef unsigned u32x2 __attribute__((ext_vector_type(2)));

constexpr int T = 16384, D = 2048, FF = 5632, SEQ = 8192, MEMT = 512;
constexpr int NWG = 256, NTHR = 512;
constexpr float EPS = 1e-6f;

constexpr size_t WS_BAR   = 0;
constexpr size_t WS_SS    = 16384;
constexpr size_t WS_ALR   = WS_SS + 4ull * T * 32 * 4;
constexpr size_t WS_BEND  = WS_ALR + (size_t)T * 16 * 4;
constexpr size_t WS_MEMH  = WS_BEND + 1024ull * 128 * 4;
constexpr size_t WS_MEMK  = WS_MEMH + (size_t)MEMT * D * 2;
constexpr size_t WS_MEMVT = WS_MEMK + (size_t)MEMT * D * 2;
constexpr size_t WS_W1GU  = WS_MEMVT + (size_t)MEMT * D * 2;
constexpr size_t WS_W1D   = WS_W1GU + 2ull * FF * D * 2;
constexpr size_t WS_W2GU  = WS_W1D + (size_t)FF * D * 2;
constexpr size_t WS_W2D   = WS_W2GU + 2ull * FF * D * 2;
constexpr size_t WS_WIN   = WS_W2D + (size_t)FF * D * 2;
constexpr size_t WS_WA    = WS_WIN + 4096ull * D * 2;
constexpr size_t WS_POOLW = WS_WA + 16ull * D * 2;
constexpr size_t WS_WOUT  = WS_POOLW + 4ull * 256 * 256 * 2;
constexpr size_t WS_WQ    = WS_WOUT + (size_t)D * D * 2;
constexpr size_t WS_WKV   = WS_WQ + (size_t)D * D * 2;
constexpr size_t WS_WO    = WS_WKV + 2ull * D * D * 2;
constexpr size_t WS_H     = WS_WO + (size_t)D * D * 2;
constexpr size_t WS_ACT   = WS_H + (size_t)T * D * 2;
constexpr size_t WS_MIX   = WS_ACT + (size_t)T * FF * 2;
constexpr size_t WS_RS0   = WS_MIX + (size_t)T * D * 2;
constexpr size_t WS_END   = WS_RS0 + (size_t)T * 4;
constexpr size_t ACT_KT   = (size_t)T * 4096 * 2;
constexpr size_t ACT_VT   = ACT_KT + 1024ull * 8192 * 2;
constexpr size_t ACT_PATT = (size_t)T * D * 2;
constexpr size_t ACT_WQK  = ACT_KT;
constexpr size_t ACT_VWOT = ACT_WQK + 2ull * 1024 * D * 2;

constexpr int LDS_BYTES = 139264;

typedef __bf16 bf16x2_t __attribute__((ext_vector_type(2)));
__device__ __forceinline__ unsigned cvt_pk_bf16(float lo, float hi) { const f32x2 v = {lo, hi}; const bf16x2_t r = __builtin_convertvector(v, bf16x2_t); return __builtin_bit_cast(unsigned, r); }
__device__ __forceinline__ u32x4 pair16(u32x2 a, u32x2 b) {
    const auto rx = __builtin_amdgcn_permlane16_swap(a.x, b.x, false, false); const auto ry = __builtin_amdgcn_permlane16_swap(a.y, b.y, false, false);
    return (u32x4){rx[0], ry[0], rx[1], ry[1]};
}
template <int CTRL> __device__ __forceinline__ unsigned dpp_quad(unsigned x) { return (unsigned)__builtin_amdgcn_mov_dpp((int)x, CTRL, 0xf, 0xf, true); }
__device__ __forceinline__ float bf_lo(unsigned w) { return __uint_as_float(w << 16); }
__device__ __forceinline__ float bf_hi(unsigned w) { return __uint_as_float(w & 0xffff0000u); }
__device__ __forceinline__ float silu_f(float g) { return g * __builtin_amdgcn_rcpf(1.0f + __builtin_amdgcn_exp2f(-1.44269504f * g)); }
__device__ __forceinline__ float rstd_of(const float* ss, int row) {
    const f32x4* q = (const f32x4*)(ss + (size_t)row * 32); float s = 0.f;
#pragma unroll
    for (int j = 0; j < 8; ++j) { const f32x4 v = q[j]; s += (v[0] + v[1]) + (v[2] + v[3]); }
    return rsqrtf(s * (1.0f / 2048.0f) + EPS); }

namespace pg8 {
constexpr int BM = 256, BK = 64, HALF = 128, HTB = HALF * BK * 2, STAGE_BYTES = 8 * HTB, NXCD = 8, WGM = 8;
__device__ __forceinline__ int lds_byte(int r, int c) { const int st = (r >> 4) * 2 + (c >> 5), rr = r & 15, cc = c & 31, ob = rr * 64 + cc * 2; return st * 1024 + (ob ^ (((ob >> 9) & 1) << 5)); }
__device__ __forceinline__ void stage_rc(int b, int& R, int& C) { const int st = b / 1024, sb = b % 1024, swz = sb ^ (((sb >> 9) & 1) << 5); R = (st >> 1) * 16 + swz / 64; C = (st & 1) * 32 + (swz % 64) / 2; }
__device__ __forceinline__ int perm32(int rho) { const int n = rho >> 4, i = rho & 15; return 8 * (i >> 2) + 4 * n + (i & 3); }

struct Unit { int pm, pn, z; const char* a; const char* b; size_t o; int r0, c0; };

struct StdOrder {
    int nM, nN, nwg, G, c, wgm; const char* A; const char* B; size_t ta, tb, bbatch;
    __device__ void init(int M, int N, int G_, int c_, const void* A_, size_t lda, const void* B_, size_t ldb) { nM = M / BM; nN = N / BM; nwg = nM * nN; G = G_; c = c_; A = (const char*)A_; B = (const char*)B_; ta = (size_t)BM * lda * 2; tb = (size_t)BM * ldb * 2; bbatch = 0; wgm = WGM; }
    __device__ bool next(int i, Unit& u) const {
        const long L = (long)i * G + c; if (c >= G || L >= nwg) return false;
        int wgid = (int)L; { const int q = nwg / NXCD, r = nwg % NXCD, xcd = wgid % NXCD, off = wgid / NXCD; wgid = (xcd < r ? xcd * (q + 1) : r * (q + 1) + (xcd - r) * q) + off; }
        const int nig = wgm * nN, gid = wgid / nig, fm = gid * wgm, gsz = (nM - fm) < wgm ? (nM - fm) : wgm;
        u.pm = fm + ((wgid % nig) % gsz); u.pn = (wgid % nig) / gsz; u.z = 0; u.o = 0; u.r0 = 0; u.c0 = 0; u.a = A + (size_t)u.pm * ta; u.b = B + (size_t)u.pn * tb + ((u.pm >= (nM >> 1)) ? bbatch : (size_t)0); return true;
    }
};

template <bool ALIGN_EPI, class Epi, class Sched>
__device__ __forceinline__ void gemm_phase(LAS unsigned char* lds, const int lda, const int ldb, const int K, const Sched& S, const Epi& E, const size_t kstepA = (size_t)(BK * 2), const size_t kstepB = (size_t)(BK * 2)) {
    int tid = threadIdx.x; asm volatile("" : "+v"(tid));
    const int wid = __builtin_amdgcn_readfirstlane(tid >> 6), lane = tid & 63, wr = wid >> 2, wc = wid & 3, fr = lane & 15, fq = lane >> 4;
    const int nt = K / BK;
    unsigned voffA[2], voffB[2];
#pragma unroll
    for (int i = 0; i < 2; ++i) { int R, C; stage_rc(tid * 16 + i * 8192, R, C); const int Rb = (R & ~31) + perm32(R & 31);
        voffA[i] = (unsigned)(R * lda + C) * 2u; voffB[i] = (unsigned)(Rb * ldb + C) * 2u; }
    const size_t kstep = kstepB;
    const size_t hstepA = (size_t)HALF * lda * 2, hstepB = (size_t)HALF * ldb * 2;
    const unsigned ldsw = (unsigned)wid * 1024u;
    const int aoff = lds_byte(wr * 64 + fr, fq * 8), boff = lds_byte(wc * 32 + fr, fq * 8);
#define PG8_SA(b, h) (((b) * 2 + (h)) * HTB)
#define PG8_SB(b, h) ((4 + (b) * 2 + (h)) * HTB)
#define PG8_STAGE(bufoff, gbase, voff) do { _Pragma("unroll") for (int _i = 0; _i < 2; ++_i) \
        __builtin_amdgcn_global_load_lds((const unsigned*)((const char*)(gbase) + (voff)[_i]), (LAS unsigned*)(lds + (bufoff) + ldsw + _i * 8192), 16, 0, 0); } while (0)
#define PG8_LDA(dst, b, h) do { _Pragma("unroll") for (int m = 0; m < 4; ++m) _Pragma("unroll") for (int k = 0; k < 2; ++k) dst[m][k] = *(const LAS bf16x8*)(lds + PG8_SA(b, h) + aoff + m * 2048 + k * 1024); } while (0)
#define PG8_LDB(dst, b, h) do { _Pragma("unroll") for (int n = 0; n < 2; ++n) _Pragma("unroll") for (int k = 0; k < 2; ++k) dst[n][k] = *(const LAS bf16x8*)(lds + PG8_SB(b, h) + boff + n * 2048 + k * 1024); } while (0)
#define PG8_MMA(ai, bj, At, Bt) do { __builtin_amdgcn_s_setprio(1); _Pragma("unroll") for (int m = 0; m < 4; ++m) _Pragma("unroll") for (int n = 0; n < 2; ++n) _Pragma("unroll") for (int k = 0; k < 2; ++k) \
        acc[ai][bj][m][n] = __builtin_amdgcn_mfma_f32_16x16x32_bf16(Bt[n][k], At[m][k], acc[ai][bj][m][n], 0, 0, 0); __builtin_amdgcn_s_setprio(0); } while (0)
#define PG8_WAIT_V(n) asm volatile("s_waitcnt vmcnt(" #n ")" ::: "memory")
#define PG8_WAIT_L(n) asm volatile("s_waitcnt lgkmcnt(" #n ")" ::: "memory")
#define PG8_BAR __builtin_amdgcn_s_barrier()
#define PG8_SCHED __builtin_amdgcn_sched_barrier(0)
    Unit cur, nxt; int ui = 0;
    if (!S.next(0, cur)) return;
    f32x4 acc[2][2][4][2];
#pragma unroll
    for (int a = 0; a < 2; ++a)
#pragma unroll
        for (int b = 0; b < 2; ++b)
#pragma unroll
            for (int m = 0; m < 4; ++m)
#pragma unroll
                for (int n = 0; n < 2; ++n) acc[a][b][m][n] = (f32x4){0.f, 0.f, 0.f, 0.f};
    bf16x8 At[4][2], B0[2][2], B1[2][2];
    const char* cA = cur.a; const char* cB = cur.b;
    PG8_STAGE(PG8_SB(0, 0), cB, voffB); PG8_STAGE(PG8_SB(0, 1), cB + hstepB, voffB); PG8_STAGE(PG8_SA(0, 0), cA, voffA); PG8_STAGE(PG8_SA(0, 1), cA + hstepA, voffA);
    if (wr == 1) PG8_BAR;
    PG8_WAIT_V(2); PG8_BAR;
    PG8_STAGE(PG8_SB(1, 0), cB + kstep, voffB); PG8_STAGE(PG8_SA(1, 0), cA + kstepA, voffA); PG8_STAGE(PG8_SB(1, 1), cB + hstepB + kstep, voffB);
    PG8_WAIT_V(6); PG8_BAR;
    for (;;) {
        const bool has_next = S.next(ui + 1, nxt);
        const char* nA = has_next ? nxt.a : cA; const char* nB = has_next ? nxt.b : cB;
#pragma unroll 1
        for (int t = 0; t < nt; t += 2) {
            const bool last = (t == nt - 2);
            const char* a1 = cA + (size_t)(t + 1) * kstepA;
            const char* a2 = last ? nA : cA + (size_t)(t + 2) * kstepA; const char* b2 = last ? nB : cB + (size_t)(t + 2) * kstep;
            const char* a3 = a2 + kstepA; const char* b3 = b2 + kstep;
            PG8_LDB(B0, 0, 0); PG8_LDB(B1, 0, 1); PG8_SCHED; PG8_LDA(At, 0, 0); PG8_STAGE(PG8_SA(1, 1), a1 + hstepA, voffA);
            PG8_WAIT_V(8); PG8_WAIT_L(0); PG8_BAR; PG8_MMA(0, 0, At, B0); PG8_MMA(0, 1, At, B1); PG8_BAR; PG8_SCHED;
            PG8_LDA(At, 0, 1); PG8_STAGE(PG8_SB(0, 0), b2, voffB); PG8_STAGE(PG8_SB(0, 1), b2 + hstepB, voffB); PG8_STAGE(PG8_SA(0, 0), a2, voffA);
            PG8_WAIT_V(8); PG8_WAIT_L(0); PG8_BAR; PG8_MMA(1, 0, At, B0); PG8_MMA(1, 1, At, B1); PG8_BAR; PG8_SCHED;
            PG8_LDB(B0, 1, 0); PG8_LDB(B1, 1, 1); PG8_SCHED; PG8_LDA(At, 1, 0); PG8_STAGE(PG8_SA(0, 1), a2 + hstepA, voffA);
            PG8_WAIT_V(8); PG8_WAIT_L(0); PG8_BAR; PG8_MMA(0, 0, At, B0); PG8_MMA(0, 1, At, B1); PG8_BAR; PG8_SCHED;
            PG8_LDA(At, 1, 1); PG8_STAGE(PG8_SB(1, 0), b3, voffB); PG8_STAGE(PG8_SB(1, 1), b3 + hstepB, voffB); PG8_STAGE(PG8_SA(1, 0), a3, voffA);
            PG8_WAIT_V(8); PG8_WAIT_L(0); PG8_BAR; PG8_MMA(1, 0, At, B0); PG8_MMA(1, 1, At, B1); PG8_BAR; PG8_SCHED;
        }
        if constexpr (ALIGN_EPI) { if (wr == 0) PG8_BAR; }
        if constexpr (!Epi::AFTER_DRAIN) { E(acc, cur, wr, wc, fr, fq); }
        if (!has_next) break;
#pragma unroll
        for (int a = 0; a < 2; ++a)
#pragma unroll
            for (int b = 0; b < 2; ++b)
#pragma unroll
                for (int m = 0; m < 4; ++m)
#pragma unroll
                    for (int n = 0; n < 2; ++n) acc[a][b][m][n] = (f32x4){0.f, 0.f, 0.f, 0.f};
        cur = nxt; cA = nA; cB = nB; ++ui;
        if constexpr (ALIGN_EPI) { if (wr == 1) PG8_BAR; }
    }
    PG8_WAIT_V(0);
    if constexpr (!ALIGN_EPI) { if (wr == 0) PG8_BAR; }
    PG8_BAR;
    if constexpr (Epi::AFTER_DRAIN) { E.fused(acc, cur, wr, wc, fr, fq, lds, wid, lane); }
#undef PG8_SA
#undef PG8_SB
#undef PG8_STAGE
#undef PG8_LDA
#undef PG8_LDB
#undef PG8_MMA
#undef PG8_WAIT_V
#undef PG8_WAIT_L
#undef PG8_BAR
#undef PG8_SCHED
}

typedef f32x4 Acc[2][2][4][2];

struct EpiSwiglu {
    static constexpr bool AFTER_DRAIN = false;
    bf16_t* O; const float* ss;
    __device__ __forceinline__ void operator()(const Acc& acc, const Unit& u, int wr, int wc, int fr, int fq) const {
        const int row0 = u.pm * BM + wr * 64 + fr, col0 = u.pn * 128 + wc * 32 + 8 * fq;
#pragma unroll
        for (int ai = 0; ai < 2; ++ai)
#pragma unroll
            for (int m = 0; m < 4; ++m) { const int row = row0 + ai * HALF + m * 16; const float rs = ss ? rstd_of(ss, row) : 1.0f;
                const f32x4 g0 = acc[ai][0][m][0] * rs, g1 = acc[ai][0][m][1] * rs, u0 = acc[ai][1][m][0] * rs, u1 = acc[ai][1][m][1] * rs;
                u32x4 w; w.x = cvt_pk_bf16(silu_f(g0[0]) * u0[0], silu_f(g0[1]) * u0[1]); w.y = cvt_pk_bf16(silu_f(g0[2]) * u0[2], silu_f(g0[3]) * u0[3]);
                w.z = cvt_pk_bf16(silu_f(g1[0]) * u1[0], silu_f(g1[1]) * u1[1]); w.w = cvt_pk_bf16(silu_f(g1[2]) * u1[2], silu_f(g1[3]) * u1[3]);
                *(u32x4*)(O + ((size_t)(col0 >> 6) * T + row) * 64 + (col0 & 63)) = w; }
    }
};
struct EpiResid {
    static constexpr bool AFTER_DRAIN = false;
    bf16_t* xs; const float* gprev; const float* rsprev; const float* gain; float* ss; float alpha;
    __device__ __forceinline__ void operator()(const Acc& acc, const Unit& u, int wr, int wc, int fr, int fq) const {
        const int row0 = u.pm * BM + wr * 64 + fr, col0 = u.pn * BM + wc * 32 + 8 * fq;
        f32x4 gv[2][2], gi[2][2];
#pragma unroll
        for (int bj = 0; bj < 2; ++bj)
#pragma unroll
            for (int n = 0; n < 2; ++n) { gv[bj][n] = *(const f32x4*)(gain + col0 + bj * HALF + 4 * n); const f32x4 gp = *(const f32x4*)(gprev + col0 + bj * HALF + 4 * n);
                gi[bj][n] = (f32x4){1.0f / gp[0], 1.0f / gp[1], 1.0f / gp[2], 1.0f / gp[3]}; }
#pragma unroll
        for (int ai = 0; ai < 2; ++ai)
#pragma unroll
            for (int m = 0; m < 4; ++m) { const int row = row0 + ai * HALF + m * 16; const float rinv = rsprev ? 1.0f / rsprev[row] : 1.0f; float s = 0.f;
#pragma unroll
                for (int bj = 0; bj < 2; ++bj) { const int cx = col0 + bj * HALF; bf16_t* px = xs + ((size_t)(cx >> 6) * T + row) * 64 + (cx & 63);
                    const u32x4 pv = *(const u32x4*)px;
                    const f32x4 x0 = (f32x4){bf_lo(pv.x), bf_hi(pv.x), bf_lo(pv.y), bf_hi(pv.y)} * gi[bj][0] * rinv, x1 = (f32x4){bf_lo(pv.z), bf_hi(pv.z), bf_lo(pv.w), bf_hi(pv.w)} * gi[bj][1] * rinv;
                    const f32x4 y0 = x0 + acc[ai][bj][m][0] * alpha, y1 = x1 + acc[ai][bj][m][1] * alpha;
                    s += (y0[0] * y0[0] + y0[1] * y0[1]) + (y0[2] * y0[2] + y0[3] * y0[3]) + (y1[0] * y1[0] + y1[1] * y1[1]) + (y1[2] * y1[2] + y1[3] * y1[3]);
                    const f32x4 a = y0 * gv[bj][0], b = y1 * gv[bj][1]; u32x4 w; w.x = cvt_pk_bf16(a[0], a[1]); w.y = cvt_pk_bf16(a[2], a[3]); w.z = cvt_pk_bf16(b[0], b[1]); w.w = cvt_pk_bf16(b[2], b[3]);
                    *(u32x4*)px = w; }
                s += __shfl_xor(s, 16); s += __shfl_xor(s, 32);
                if (fq == 0) ss[(size_t)row * 32 + u.pn * 4 + wc] = s;
                asm volatile("" ::: "memory"); }
    }
};
__device__ __forceinline__ void store_nat(const Acc& acc, bf16_t* base, size_t ldc, int row0, int col0, const float* ss) {
#pragma unroll
    for (int ai = 0; ai < 2; ++ai)
#pragma unroll
        for (int m = 0; m < 4; ++m) { const int row = row0 + ai * HALF + m * 16; const float rs = ss ? rstd_of(ss, row) : 1.0f;
#pragma unroll
            for (int bj = 0; bj < 2; ++bj) { const f32x4 a = acc[ai][bj][m][0] * rs, b = acc[ai][bj][m][1] * rs; u32x4 w; w.x = cvt_pk_bf16(a[0], a[1]); w.y = cvt_pk_bf16(a[2], a[3]); w.z = cvt_pk_bf16(b[0], b[1]); w.w = cvt_pk_bf16(b[2], b[3]);
                *(u32x4*)(base + (size_t)row * ldc + col0 + bj * HALF) = w; } }
}
struct EpiWin {
    static constexpr bool AFTER_DRAIN = false;
    bf16_t* P; bf16_t* KT; bf16_t* VT; const float* ss;
    __device__ __forceinline__ void operator()(const Acc& acc, const Unit& u, int wr, int wc, int fr, int fq) const {
        const int row0 = u.pm * BM + wr * 64 + fr;
        if (u.pn < 6 || u.pn >= 12) { store_nat(acc, P, 4096, row0, u.pn * BM + wc * 32 + 8 * fq, ss); return; }
        const bool isk = u.pn < 8;
#pragma unroll
        for (int ai = 0; ai < 2; ++ai) { const int chunk = u.pm * 4 + ai * 2 + wr;
#pragma unroll
            for (int m = 0; m < 4; ++m) { const int row = row0 + ai * HALF + m * 16; const float rs = rstd_of(ss, row); const int i = m * 16 + fr;
#pragma unroll
                for (int bj = 0; bj < 2; ++bj)
#pragma unroll
                    for (int n = 0; n < 2; ++n) { const f32x4 a = acc[ai][bj][m][n] * rs; const int c = bj * HALF + wc * 32 + 8 * fq + 4 * n;
                        const unsigned p0 = cvt_pk_bf16(a[0], a[1]), p1 = cvt_pk_bf16(a[2], a[3]);
                        const int t4 = fr & 3; const bool odd = (t4 & 1) != 0, hi2 = (t4 & 2) != 0;
                        const unsigned own1 = odd ? p1 : p0, rcv1 = dpp_quad<0xB1>(odd ? p0 : p1);
                        const unsigned first = odd ? rcv1 : own1, second = odd ? own1 : rcv1;
                        const unsigned qa = (first & 0xffffu) | (second << 16), qb = (first >> 16) | (second & 0xffff0000u);
                        const unsigned own2 = hi2 ? qb : qa, rcv2 = dpp_quad<0x4E>(hi2 ? qa : qb);
                        u32x2 w; w.x = hi2 ? rcv2 : own2; w.y = hi2 ? own2 : rcv2;
                        const int cf = c + (((t4 & 1) << 1) | (t4 >> 1)), i4 = i & ~3;
                        bf16_t* dst;
                        if (isk) { const int kf = (u.pn - 6) * 256 + cf; dst = KT + ((size_t)(chunk * 4 + (kf >> 7)) * 8192 + (size_t)(kf & 127) * 64 + i4); }
                        else { dst = VT + ((size_t)(chunk * 4 + (u.pn - 8)) * 16384 + (size_t)cf * 64 + i4); }
                        *(u32x2*)dst = w; } } }
    }
};
struct EpiMemKV {
    static constexpr bool AFTER_DRAIN = false;
    bf16_t* MK; bf16_t* MV;
    __device__ __forceinline__ void operator()(const Acc& acc, const Unit& u, int wr, int wc, int fr, int fq) const {
        const int h = (u.pn & 7) >> 1, d0 = (u.pn & 1) * 256; bf16_t* base = (u.pn < 8 ? MK : MV) + (size_t)(u.pm * 4 + h) * 256 * 512;
        store_nat(acc, base, 512, wr * 64 + fr, d0 + wc * 32 + 8 * fq, nullptr);
    }
};
struct EpiTile {
    static constexpr bool AFTER_DRAIN = false;
    bf16_t* O; size_t NR;
    __device__ __forceinline__ void operator()(const Acc& acc, const Unit& u, int wr, int wc, int fr, int fq) const {
        bf16_t* base = O + u.o;
#pragma unroll
        for (int ai = 0; ai < 2; ++ai)
#pragma unroll
            for (int m = 0; m < 4; ++m) { const int row = u.r0 + ai * HALF + wr * 64 + m * 16 + fr;
#pragma unroll
                for (int bj = 0; bj < 2; ++bj) { const int col = u.c0 + bj * HALF + wc * 32 + 8 * fq; const f32x4 a = acc[ai][bj][m][0], b = acc[ai][bj][m][1];
                    u32x4 w; w.x = cvt_pk_bf16(a[0], a[1]); w.y = cvt_pk_bf16(a[2], a[3]); w.z = cvt_pk_bf16(b[0], b[1]); w.w = cvt_pk_bf16(b[2], b[3]);
                    *(u32x4*)(base + ((size_t)(col >> 6) * NR + row) * 64 + (col & 63)) = w; } }
    }
};
struct EpiSoftmax {
    static constexpr bool AFTER_DRAIN = true;
    bf16_t* Pout; const float* ss;
    __device__ __forceinline__ void operator()(const Acc&, const Unit&, int, int, int, int) const {}
    __device__ __forceinline__ void fused(Acc& acc, const Unit& u, int wr, int wc, int fr, int fq, LAS unsigned char* lds, int wid, int lane) const {
        LAS float* X = (LAS float*)lds; LAS float* Y = (LAS float*)(lds + 4096);
        const float sc = 0.04419417382f * 1.44269504f;
#pragma unroll
        for (int ai = 0; ai < 2; ++ai)
#pragma unroll
            for (int m = 0; m < 4; ++m) { float mx = -3.0e38f; const float rs = rstd_of(ss, u.pm * BM + ai * HALF + wr * 64 + m * 16 + fr);
#pragma unroll
                for (int bj = 0; bj < 2; ++bj)
#pragma unroll
                    for (int n = 0; n < 2; ++n) { const f32x4 a = acc[ai][bj][m][n] * rs; acc[ai][bj][m][n] = a; mx = fmaxf(mx, fmaxf(fmaxf(a[0], a[1]), fmaxf(a[2], a[3]))); }
                mx = fmaxf(mx, __shfl_xor(mx, 16)); mx = fmaxf(mx, __shfl_xor(mx, 32));
                if (fq == 0) X[(ai * HALF + wr * 64 + m * 16 + fr) * 4 + wc] = mx; }
        asm volatile("s_waitcnt lgkmcnt(0)" ::: "memory"); __builtin_amdgcn_s_barrier(); asm volatile("" ::: "memory");
#pragma unroll
        for (int ai = 0; ai < 2; ++ai)
#pragma unroll
            for (int m = 0; m < 4; ++m) { const int r = ai * HALF + wr * 64 + m * 16 + fr; const f32x4 mv = *(const LAS f32x4*)(X + r * 4);
                const float rm = fmaxf(fmaxf(mv[0], mv[1]), fmaxf(mv[2], mv[3])) * sc; float s = 0.f;
#pragma unroll
                for (int bj = 0; bj < 2; ++bj)
#pragma unroll
                    for (int n = 0; n < 2; ++n) { f32x4 a = acc[ai][bj][m][n];
#pragma unroll
                        for (int j = 0; j < 4; ++j) { a[j] = __builtin_amdgcn_exp2f(a[j] * sc - rm); s += a[j]; }
                        acc[ai][bj][m][n] = a; }
                s += __shfl_xor(s, 16); s += __shfl_xor(s, 32);
                if (fq == 0) Y[r * 4 + wc] = s; }
        asm volatile("s_waitcnt lgkmcnt(0)" ::: "memory"); __builtin_amdgcn_s_barrier(); asm volatile("" ::: "memory");
        const int row0 = u.pm * BM + wr * 64 + fr, col0 = u.z * 256 + wc * 32 + 8 * fq;
#pragma unroll
        for (int ai = 0; ai < 2; ++ai)
#pragma unroll
            for (int m = 0; m < 4; ++m) { const int r = ai * HALF + wr * 64 + m * 16 + fr; const f32x4 sv = *(const LAS f32x4*)(Y + r * 4);
                const float inv = 1.0f / ((sv[0] + sv[1]) + (sv[2] + sv[3])); const int row = row0 + ai * HALF + m * 16;
#pragma unroll
                for (int bj = 0; bj < 2; ++bj) { const f32x4 a = acc[ai][bj][m][0] * inv, b = acc[ai][bj][m][1] * inv; u32x4 w; w.x = cvt_pk_bf16(a[0], a[1]); w.y = cvt_pk_bf16(a[2], a[3]); w.z = cvt_pk_bf16(b[0], b[1]); w.w = cvt_pk_bf16(b[2], b[3]);
                    const int cp = col0 + bj * HALF; *(u32x4*)(Pout + ((size_t)(cp >> 6) * T + row) * 64 + (cp & 63)) = w; } }
    }
};
struct WinFoldOrder {
    int c; const char* PW; const char* WINU;
    __device__ bool next(int i, Unit& u) const { if (i > 0 || c < 0 || c >= 32) return false; const int g = c >> 3; u.pm = g; u.z = 0; u.pn = c & 7;
        u.a = PW + (size_t)g * 65536 * 2; u.b = WINU + ((size_t)u.pn * 256 * 1024 + g * 256) * 2; u.o = 0; u.r0 = g * 256; u.c0 = u.pn * 256; return true; }
};
struct WqKOrder {
    int c; const char* MK; const char* WQN;
    __device__ bool next(int i, Unit& u) const { if (i > 0 || c < 0 || c >= 64) return false; const int b = c >> 5, h = (c >> 3) & 3; u.pm = b; u.z = h; u.pn = c & 7;
        u.a = MK + (size_t)((b * 4 + h) * 256 * 512) * 2; u.b = WQN + ((size_t)u.pn * 256 * D + h * 512) * 2; u.o = (size_t)b * 1024 * D; u.r0 = h * 256; u.c0 = u.pn * 256; return true; }
};
struct VWoOrder {
    int c; const char* WOT; const char* MV;
    __device__ bool next(int i, Unit& u) const { if (i > 0 || c < 0 || c >= 64) return false; const int b = c >> 5, h = (c >> 3) & 3; u.pm = c & 7; u.z = h; u.pn = 0;
        u.a = WOT + ((size_t)u.pm * 256 * D + h * 512) * 2; u.b = MV + (size_t)((b * 4 + h) * 256 * 512) * 2; u.o = (size_t)b * D * 1024; u.r0 = u.pm * 256; u.c0 = h * 256; return true; }
};
struct LogitOrder {
    int c; const char* A; const char* WQK;
    __device__ bool next(int i, Unit& u) const { if (i > 0 || c >= 256) return false; const int v = (c & 7) * 32 + (c >> 3); u.pm = v >> 2; u.z = v & 3; u.pn = 0; u.o = 0;
        u.a = A + (size_t)u.pm * 256 * 64 * 2; u.b = WQK + ((size_t)(u.pm >> 5) * 1024 * D + (size_t)u.z * 256 * 64) * 2; return true; }
};
struct MemKVOrder {
    int c; const char* A; const char* B;
    __device__ bool next(int i, Unit& u) const { if (i > 0 || c >= 32 || c < 0) return false; u.pm = c & 1; u.pn = c >> 1; u.z = 0; u.o = 0; u.a = A + (size_t)u.pm * 256 * D * 2; u.b = B + (size_t)u.pn * 256 * D * 2; return true; }
};
}

struct Params {
    const float *x, *mem, *ffn1_norm, *ffn1_wg, *ffn1_wu, *ffn1_wd, *mix_norm, *w_in, *pool_w, *pool_scale, *gla_w_a2, *gla_b_a, *gla_head_norm, *w_out,
        *xattn_norm, *mem_norm, *wq, *wkv, *wo, *ffn2_norm, *ffn2_wg, *ffn2_wu, *ffn2_wd, *final_norm;
    float* out; unsigned char* ws;
};

__device__ __forceinline__ float wave_sum(float v) {
#pragma unroll
    for (int o = 1; o < 64; o <<= 1) v += __shfl_xor(v, o);
    return v;
}

__device__ __forceinline__ void conv_item(const float* W, int K, int ld, int nblk, bf16_t* WT, int mode, LAS float* scr, int item, int lane, int tiledNR = 0) {
    const int kb = item / nblk, nb = item - kb * nblk, k0 = 64 * kb, n0 = 64 * nb;
    const float* src = W + (size_t)k0 * ld + n0 + lane;
    float tv[64];
#pragma unroll
    for (int kk = 0; kk < 64; ++kk) tv[kk] = __builtin_nontemporal_load(src + (size_t)kk * ld);
#pragma unroll
    for (int kk = 0; kk < 64; ++kk) scr[kk * 65 + lane] = tv[kk];
    asm volatile("s_waitcnt lgkmcnt(0)" ::: "memory");
    const int c = lane & 7;
    const int rbase = (mode == 0) ? n0 : ((n0 >> 7) * 256 + (n0 & 127) + (mode == 2 ? 128 : 0));
#pragma unroll
    for (int j = 0; j < 8; ++j) { const int n = (lane >> 3) + 8 * j; const LAS float* s = scr + (8 * c) * 65 + n;
        u32x4 o; o.x = cvt_pk_bf16(s[0], s[65]); o.y = cvt_pk_bf16(s[2 * 65], s[3 * 65]); o.z = cvt_pk_bf16(s[4 * 65], s[5 * 65]); o.w = cvt_pk_bf16(s[6 * 65], s[7 * 65]);
        if (tiledNR) *(u32x4*)(WT + ((size_t)(k0 >> 6) * tiledNR + rbase + n) * 64 + 8 * c) = o; else *(u32x4*)(WT + (size_t)(rbase + n) * K + k0 + 8 * c) = o; }
    asm volatile("s_waitcnt lgkmcnt(0)" ::: "memory");
}
template <bool TILED>
__device__ __forceinline__ void rms_row_to_bf16(const float* xrow, const float* gain, bf16_t* obase, int m, int lane, float* rsout = nullptr) {
    f32x4 v[8]; float s = 0.f;
#pragma unroll
    for (int j = 0; j < 8; ++j) { v[j] = *(const f32x4*)(xrow + 4 * lane + 256 * j); s += (v[j][0] * v[j][0] + v[j][1] * v[j][1]) + (v[j][2] * v[j][2] + v[j][3] * v[j][3]); }
    const float rs = rsqrtf(wave_sum(s) * (1.0f / 2048.0f) + EPS);
    if (rsout && lane == 0) rsout[m] = rs;
#pragma unroll
    for (int j = 0; j < 8; ++j) { const f32x4 g = *(const f32x4*)(gain + 4 * lane + 256 * j); const f32x4 y = v[j] * g * rs; u32x2 w; w.x = cvt_pk_bf16(y[0], y[1]); w.y = cvt_pk_bf16(y[2], y[3]);
        const int c = 4 * lane + 256 * j;
        if (TILED) *(u32x2*)(obase + ((size_t)(c >> 6) * T + m) * 64 + (c & 63)) = w; else *(u32x2*)(obase + (size_t)m * D + c) = w; }
}

template <int W>
__device__ __forceinline__ void pool_elem(const bf16_t* PN, const float* pscale, bf16_t* MIX, int tA, int tB, bool hasB, int c) {
    const int tt[2] = {tA, hasB ? tB : tA};
    u32x4 cj[2][W]; int cnt[2];
#pragma unroll
    for (int q = 0; q < 2; ++q) { const int spos = tt[q] & (SEQ - 1); cnt[q] = (spos + 1 < W) ? spos + 1 : W; const char* up = (const char*)(PN + (size_t)tt[q] * 4096 + c);
#pragma unroll
        for (int j = 0; j < W; ++j) { const unsigned jj = (j < cnt[q]) ? (unsigned)j : 0u; cj[q][j] = *(const u32x4*)(up - jj * 8192u); } }
    const f32x4 p0 = *(const f32x4*)(pscale + c), p1 = *(const f32x4*)(pscale + c + 4);
#pragma unroll
    for (int q = 0; q < 2; ++q) { const float inv = 1.0f / (float)cnt[q];
        float s[8] = {0.f, 0.f, 0.f, 0.f, 0.f, 0.f, 0.f, 0.f};
#pragma unroll
        for (int j = 0; j < W; ++j) { const float m = (j < cnt[q]) ? 1.0f : 0.0f; const u32x4 v = cj[q][j];
            s[0] += m * bf_lo(v.x); s[1] += m * bf_hi(v.x); s[2] += m * bf_lo(v.y); s[3] += m * bf_hi(v.y);
            s[4] += m * bf_lo(v.z); s[5] += m * bf_hi(v.z); s[6] += m * bf_lo(v.w); s[7] += m * bf_hi(v.w); }
        const u32x4 z0 = cj[q][0];
        u32x4 w; w.x = cvt_pk_bf16((s[0] * inv - bf_lo(z0.x)) * p0[0], (s[1] * inv - bf_hi(z0.x)) * p0[1]); w.y = cvt_pk_bf16((s[2] * inv - bf_lo(z0.y)) * p0[2], (s[3] * inv - bf_hi(z0.y)) * p0[3]);
        w.z = cvt_pk_bf16((s[4] * inv - bf_lo(z0.z)) * p1[0], (s[5] * inv - bf_hi(z0.z)) * p1[1]); w.w = cvt_pk_bf16((s[6] * inv - bf_lo(z0.w)) * p1[2], (s[7] * inv - bf_hi(z0.w)) * p1[3]);
        if (q == 0 || hasB) *(u32x4*)(MIX + ((size_t)(c >> 6) * T + tt[q]) * 64 + (c & 63)) = w; }
}

#define XB_TMO      128
#define XB_XCNT(j)  (256  + 64 * (j))
#define XB_XSUB(j)  (1280 + 64 * (j))
#define XB_XGEN(j)  (2304 + 64 * (j))
#define XB_TOP      3328
#define XB_TOPGEN   3392
#define XCD_BAR_WORDS 3456
#define XB_SPIN_CAP (1u << 18)

__device__ __forceinline__ unsigned xb_ld(unsigned* p)              { return __hip_atomic_load(p, __ATOMIC_RELAXED, __HIP_MEMORY_SCOPE_AGENT); }
__device__ __forceinline__ unsigned xb_add(unsigned* p, unsigned v) { return __hip_atomic_fetch_add(p, v, __ATOMIC_RELAXED, __HIP_MEMORY_SCOPE_AGENT); }
__device__ __forceinline__ unsigned xb_xcc_id() { return (unsigned)__builtin_amdgcn_s_getreg((3 << 11) | 20) & 0xFu; }
#define XB_SPIN(cond, bar) do { unsigned _sp = 0; while (cond) { __builtin_amdgcn_s_sleep(1); \
    if ((++_sp & 255u) == 0u) { if (xb_ld(&(bar)[XB_TMO])) break; if (_sp > XB_SPIN_CAP) { atomicAdd(&(bar)[XB_TMO], 1u); break; } } } } while (0)

struct XcdBarrier {
    unsigned* bar; unsigned x;
    volatile LAS unsigned* st;
};

__device__ __forceinline__ XcdBarrier xcd_barrier_post(unsigned* bar, volatile LAS unsigned* st) {
    XcdBarrier b; b.bar = bar; b.x = xb_xcc_id(); b.st = st;
    if (threadIdx.x == 0) (void)xb_add(&bar[XB_XCNT(b.x)], 1u);
    return b;
}
__device__ __forceinline__ void xcd_barrier_complete(unsigned* bar, unsigned x, unsigned& nloc, unsigned& nx) {
    const unsigned G = gridDim.x * gridDim.y * gridDim.z;
    unsigned sum, cnt, mine, sp = 0u;
    for (;;) {
        sum = 0u; cnt = 0u; mine = 0u;
#pragma unroll
        for (unsigned j = 0; j < 16; ++j) { const unsigned c = xb_ld(&bar[XB_XCNT(j)]); sum += c; cnt += (c > 0u) ? 1u : 0u; mine = (j == x) ? c : mine; }
        if (sum == G) break;
        __builtin_amdgcn_s_sleep(1);
        if ((++sp & 255u) == 0u) { if (xb_ld(&bar[XB_TMO])) break; if (sp > XB_SPIN_CAP) { atomicAdd(&bar[XB_TMO], 1u); break; } }
    }
    nloc = mine > 0u ? mine : 1u; nx = cnt > 0u ? cnt : 1u;
}

__device__ __forceinline__ void xcd_barrier(const XcdBarrier& b) {
    asm volatile("s_waitcnt vmcnt(0)" ::: "memory");
    __syncthreads();
    if (threadIdx.x == 0) {
        unsigned* bar = b.bar;
        __builtin_amdgcn_s_waitcnt(0);
        unsigned nloc = b.st[0], nx = b.st[1];
        if (nloc == 0u) { xcd_barrier_complete(bar, b.x, nloc, nx); b.st[0] = nloc; b.st[1] = nx; }
        const unsigned old = xb_add(&bar[XB_XSUB(b.x)], 1u);
        const unsigned gen = old / nloc;
        if (old + 1u == (gen + 1u) * nloc) {
            __builtin_amdgcn_fence(__ATOMIC_RELEASE, "agent");
            asm volatile("s_waitcnt vmcnt(0)" ::: "memory");
            const unsigned og = xb_add(&bar[XB_TOP], 1u);
            const unsigned tg = og / nx;
            if (og + 1u == (tg + 1u) * nx) xb_add(&bar[XB_TOPGEN], 1u);
            else XB_SPIN(xb_ld(&bar[XB_TOPGEN]) == tg, bar);
            __builtin_amdgcn_fence(__ATOMIC_ACQUIRE, "agent");
            xb_add(&bar[XB_XGEN(b.x)], 1u);
            asm volatile("s_waitcnt vmcnt(0)" ::: "memory");
        } else {
            XB_SPIN(xb_ld(&bar[XB_XGEN(b.x)]) == gen, bar);
            __builtin_amdgcn_fence(__ATOMIC_ACQUIRE, "agent");
            asm volatile("s_waitcnt vmcnt(0)" ::: "memory");
        }
    }
    __syncthreads();
}

#define GRID_SYNC() xcd_barrier(xbar)
__global__ void __launch_bounds__(NTHR, 2) fwd_megakernel(Params p) {
    extern __shared__ __attribute__((aligned(16))) unsigned char lds_raw[];
    LAS unsigned char* lds = (LAS unsigned char*)lds_raw;
    cg::grid_group grid = cg::this_grid();
    const int tid = threadIdx.x, lane = tid & 63, wave = __builtin_amdgcn_readfirstlane(tid >> 6), fr = lane & 15, fq = lane >> 4;
    const int bx = blockIdx.x, G = gridDim.x;
    const int gw = bx * 8 + wave, NGW = G * 8;
    const size_t gtid = (size_t)bx * NTHR + tid, NGT = (size_t)G * NTHR;
    unsigned char* ws = p.ws;
    volatile LAS unsigned* xst = (volatile LAS unsigned*)(lds + 133120);
    if (tid < 2) xst[tid] = 0u;
    __syncthreads();
    XcdBarrier xbar = xcd_barrier_post((unsigned*)(ws + WS_BAR), xst);
    if (p.ws == nullptr) grid.sync();
    float* SS = (float*)(ws + WS_SS); float* ALR = (float*)(ws + WS_ALR); float* BEND = (float*)(ws + WS_BEND);
    bf16_t* MEMH = (bf16_t*)(ws + WS_MEMH); bf16_t* MEMK = (bf16_t*)(ws + WS_MEMK); bf16_t* MEMVT = (bf16_t*)(ws + WS_MEMVT);
    bf16_t* W1GU = (bf16_t*)(ws + WS_W1GU); bf16_t* W1D = (bf16_t*)(ws + WS_W1D); bf16_t* W2GU = (bf16_t*)(ws + WS_W2GU); bf16_t* W2D = (bf16_t*)(ws + WS_W2D);
    bf16_t* WIN = (bf16_t*)(ws + WS_WIN); bf16_t* WA = (bf16_t*)(ws + WS_WA); bf16_t* POOLW = (bf16_t*)(ws + WS_POOLW); bf16_t* WOUT = (bf16_t*)(ws + WS_WOUT);
    bf16_t* WQ = (bf16_t*)(ws + WS_WQ); bf16_t* WKV = (bf16_t*)(ws + WS_WKV); bf16_t* WO = (bf16_t*)(ws + WS_WO);
    bf16_t* H = (bf16_t*)(ws + WS_H); bf16_t* ACT = (bf16_t*)(ws + WS_ACT); bf16_t* MIX = (bf16_t*)(ws + WS_MIX);
    bf16_t* PN = ACT; bf16_t* KT = (bf16_t*)(ws + WS_ACT + ACT_KT); bf16_t* VT = (bf16_t*)(ws + WS_ACT + ACT_VT);
    bf16_t* PATT = (bf16_t*)(ws + WS_ACT + ACT_PATT); bf16_t* WQK = (bf16_t*)(ws + WS_ACT + ACT_WQK); bf16_t* VWOT = (bf16_t*)(ws + WS_ACT + ACT_VWOT);
    bf16_t* KV = (bf16_t*)p.out;
    float* RS0 = (float*)(ws + WS_RS0);

    {
        LAS float* scr = (LAS float*)(lds + wave * 16640);
        constexpr int I_FF = (D / 64) * (FF / 64);
        constexpr int I_IN = (D / 64) * (4096 / 64);
        constexpr int I_DD = (D / 64) * (D / 64);
        constexpr int I_INR = (D / 64) * (3072 / 64);
        constexpr int NITEMS = 6 * I_FF + I_INR + 64 + I_DD * 2 + I_IN;
        for (int it = gw; it < NITEMS; it += NGW) {
            int r = it;
            if (r < I_FF) { conv_item(p.ffn1_wg, D, FF, FF / 64, W1GU, 1, scr, r, lane, 2 * FF); continue; } r -= I_FF;
            if (r < I_FF) { conv_item(p.ffn1_wu, D, FF, FF / 64, W1GU, 2, scr, r, lane, 2 * FF); continue; } r -= I_FF;
            if (r < I_FF) { conv_item(p.ffn1_wd, FF, D, D / 64, W1D, 0, scr, r, lane, D); continue; } r -= I_FF;
            if (r < I_FF) { conv_item(p.ffn2_wg, D, FF, FF / 64, W2GU, 1, scr, r, lane, 2 * FF); continue; } r -= I_FF;
            if (r < I_FF) { conv_item(p.ffn2_wu, D, FF, FF / 64, W2GU, 2, scr, r, lane, 2 * FF); continue; } r -= I_FF;
            if (r < I_FF) { conv_item(p.ffn2_wd, FF, D, D / 64, W2D, 0, scr, r, lane, D); continue; } r -= I_FF;
            if (r < I_INR) { conv_item(p.w_in + 1024, D, 4112, 3072 / 64, WIN + (size_t)1024 * 64, 0, scr, r, lane, 4096); continue; } r -= I_INR;
            if (r < 64) { const int g = r >> 4; conv_item(p.pool_w + (size_t)g * 65536, 256, 256, 4, POOLW + (size_t)g * 65536, 0, scr, r & 15, lane); continue; } r -= 64;
            if (r < I_DD) { conv_item(p.w_out, D, D, D / 64, WOUT, 0, scr, r, lane, D); continue; } r -= I_DD;
            if (r < I_DD) { conv_item(p.wo, D, D, D / 64, WO, 0, scr, r, lane); continue; } r -= I_DD;
            conv_item(p.wkv, D, 4096, 4096 / 64, WKV, 0, scr, r, lane);
        }
        for (size_t i = gtid; i < (size_t)D * D / 8; i += NGT) { const f32x4 a = ((const f32x4*)p.wq)[2 * i], b = ((const f32x4*)p.wq)[2 * i + 1];
            u32x4 w; w.x = cvt_pk_bf16(a[0], a[1]); w.y = cvt_pk_bf16(a[2], a[3]); w.z = cvt_pk_bf16(b[0], b[1]); w.w = cvt_pk_bf16(b[2], b[3]); ((u32x4*)WQ)[i] = w; }
        for (size_t i = gtid; i < (size_t)D * 1024 / 8; i += NGT) { const size_t kd = i >> 7, c = (i & 127) * 8; const float* src = p.w_in + kd * 4112 + c;
            const f32x4 a = *(const f32x4*)src, b = *(const f32x4*)(src + 4);
            u32x4 w; w.x = cvt_pk_bf16(a[0], a[1]); w.y = cvt_pk_bf16(a[2], a[3]); w.z = cvt_pk_bf16(b[0], b[1]); w.w = cvt_pk_bf16(b[2], b[3]); ((u32x4*)MIX)[i] = w; }
        for (size_t i = gtid; i < 32768; i += NGT) { const int k = (int)(i >> 4), r = (int)(i & 15); WA[r * D + k] = (bf16_t)cvt_pk_bf16(p.w_in[(size_t)k * 4112 + 4096 + r], 0.f); }
        for (int m = gw; m < T + MEMT; m += NGW) {
            if (m < T) rms_row_to_bf16<true>(p.x + (size_t)m * D, p.ffn1_norm, H, m, lane, RS0);
            else rms_row_to_bf16<false>(p.mem + (size_t)(m - T) * D, p.mem_norm, MEMH, m - T, lane);
        }
    }
    GRID_SYNC();
    { pg8::StdOrder S; S.init(T, 2 * FF, G, bx, H, 64, W1GU, 64); pg8::EpiSwiglu E{ACT, nullptr}; pg8::gemm_phase<true>(lds, 64, 64, D, S, E, (size_t)T * 64 * 2, (size_t)2 * FF * 64 * 2); }
    GRID_SYNC();
    { pg8::StdOrder S; S.init(T, D, G, bx, ACT, 64, W1D, 64); S.wgm = 4; pg8::EpiResid E{H, p.ffn1_norm, RS0, p.mix_norm, SS, 0.5f}; pg8::gemm_phase<true>(lds, 64, 64, FF, S, E, (size_t)T * 64 * 2, (size_t)D * 64 * 2); }
    { pg8::WinFoldOrder S{bx, (const char*)POOLW, (const char*)MIX}; pg8::EpiTile E{WIN, (size_t)4096}; pg8::gemm_phase<true>(lds, 256, 1024, 256, S, E); }
    GRID_SYNC();
    {
        { pg8::StdOrder S; S.init(T, 4096, G, bx, H, 64, WIN, 64); pg8::EpiWin E{PN, KT, VT, SS}; pg8::gemm_phase<true>(lds, 64, 64, D, S, E, (size_t)T * 64 * 2, (size_t)4096 * 64 * 2); }
        {
            const int tb = wave & 3, kh = wave >> 2; const int tok = bx * 64 + tb * 16 + fr;
            const bf16_t* ap = H + ((size_t)(kh * 16) * T + tok) * 64 + fq * 8; const bf16_t* wp = WA + (size_t)fr * D + kh * 1024 + fq * 8;
            f32x4 acc = {0.f, 0.f, 0.f, 0.f};
#pragma unroll 8
            for (int ks = 0; ks < 32; ++ks) { const bf16x8 wf = *(const bf16x8*)(wp + ks * 32), af = *(const bf16x8*)(ap + (size_t)(ks >> 1) * T * 64 + (ks & 1) * 32); acc = __builtin_amdgcn_mfma_f32_16x16x32_bf16(wf, af, acc, 0, 0, 0); }
            LAS f32x4* ex = (LAS f32x4*)lds;
            if (kh == 1) ex[tb * 64 + lane] = acc;
            __syncthreads();
            if (kh == 0) { const f32x4 o = (acc + ex[tb * 64 + lane]) * rstd_of(SS, tok); *(f32x4*)(ALR + (size_t)tok * 16 + 4 * fq) = o; }
        }
    }
    GRID_SYNC();
    constexpr int GA = 224;
    if (bx >= GA) { pg8::MemKVOrder S{bx - GA, (const char*)MEMH, (const char*)WKV}; pg8::EpiMemKV E{MEMK, MEMVT}; pg8::gemm_phase<true>(lds, D, D, D, S, E); }
    else {
        LAS float* alr_s = (LAS float*)lds; LAS float* w2_s = (LAS float*)(lds + 4096); LAS float* ba_s = (LAS float*)(lds + 12288); LAS float* gsum = (LAS float*)(lds + 12800);
        LAS bf16_t* KD = (LAS bf16_t*)(lds + 16384);
        {
            const int h = bx & 3; const int k = tid & 127, fg = tid >> 7;
            { const int idx = tid * 4, r = idx >> 7, kk = idx & 127; *(LAS f32x4*)(w2_s + idx) = *(const f32x4*)(p.gla_w_a2 + r * 512 + h * 128 + kk); }
            const float bk = p.gla_b_a[h * 128 + k];
            __syncthreads();
            float w[16];
#pragma unroll
            for (int r = 0; r < 16; ++r) w[r] = w2_s[r * 128 + k];
            f32x4 n_alr = {0.f, 0.f, 0.f, 0.f}; u32x4 n_k0, n_k1; bf16x8 n_vf[2][2];
#define GLA_A_PREFETCH(uu) do { if (tid < 256) n_alr = ((const f32x4*)(ALR + (size_t)((uu) >> 2) * 64 * 16))[tid]; \
                { const u32x4* kp_ = (const u32x4*)(KT + (size_t)(uu) * 8192 + (size_t)k * 64 + fg * 16); n_k0 = kp_[0]; n_k1 = kp_[1]; } \
                _Pragma("unroll") for (int vv = 0; vv < 2; ++vv) _Pragma("unroll") for (int ks = 0; ks < 2; ++ks) \
                    n_vf[vv][ks] = *(const bf16x8*)(VT + (size_t)(uu) * 16384 + (size_t)((2 * wave + vv) * 16 + fr) * 64 + ks * 32 + fq * 8); } while (0)
            GLA_A_PREFETCH(bx);
            for (int u = bx; u < 1024; u += GA) {
                const f32x4 c_alr = n_alr; const u32x4 k0 = n_k0, k1 = n_k1; bf16x8 vf[2][2];
#pragma unroll
                for (int vv = 0; vv < 2; ++vv)
#pragma unroll
                    for (int ks = 0; ks < 2; ++ks) vf[vv][ks] = n_vf[vv][ks];
                if (u + GA < 1024) GLA_A_PREFETCH(u + GA);
                if (tid < 256) ((LAS f32x4*)alr_s)[tid] = c_alr;
                __syncthreads();
                float cum[16]; float run = 0.f;
#pragma unroll
                for (int ii = 0; ii < 16; ++ii) { const int i = fg * 16 + ii; float z = bk;
#pragma unroll
                    for (int r = 0; r < 16; ++r) z += alr_s[i * 16 + r] * w[r];
                    const float la = -(fmaxf(-z, 0.f) + __logf(1.0f + __expf(-fabsf(z)))) * (1.0f / 16.0f);
                    run += la; cum[ii] = run; }
                gsum[fg * 128 + k] = run;
                __syncthreads();
                float prefix = 0.f, total = 0.f;
#pragma unroll
                for (int f = 0; f < 4; ++f) { const float gsv = gsum[f * 128 + k]; total += gsv; if (f < fg) prefix += gsv; }
                if (fg == 0) BEND[(size_t)u * 128 + k] = total;
                { const unsigned kw[8] = {k0.x, k0.y, k0.z, k0.w, k1.x, k1.y, k1.z, k1.w}; unsigned ow[8];
#pragma unroll
                  for (int q = 0; q < 8; ++q) { const float d0 = __expf(total - (cum[2 * q] + prefix)), d1 = __expf(total - (cum[2 * q + 1] + prefix)); ow[q] = cvt_pk_bf16(bf_lo(kw[q]) * d0, bf_hi(kw[q]) * d1); }
                  LAS u32x4* dst = (LAS u32x4*)(KD + k * 72 + fg * 16); dst[0] = (u32x4){ow[0], ow[1], ow[2], ow[3]}; dst[1] = (u32x4){ow[4], ow[5], ow[6], ow[7]}; }
                __syncthreads();
#pragma unroll
                for (int kp = 0; kp < 4; ++kp) { u32x2 w0[2], w1[2];
#pragma unroll
                    for (int kq = 0; kq < 2; ++kq) { const int kb = 2 * kp + kq; f32x4 a0 = {0.f, 0.f, 0.f, 0.f}, a1 = {0.f, 0.f, 0.f, 0.f};
#pragma unroll
                        for (int ks = 0; ks < 2; ++ks) { const bf16x8 kf = *(const LAS bf16x8*)(KD + (kb * 16 + fr) * 72 + ks * 32 + fq * 8);
                            a0 = __builtin_amdgcn_mfma_f32_16x16x32_bf16(kf, vf[0][ks], a0, 0, 0, 0); a1 = __builtin_amdgcn_mfma_f32_16x16x32_bf16(kf, vf[1][ks], a1, 0, 0, 0); }
                        w0[kq].x = cvt_pk_bf16(a0[0], a0[1]); w0[kq].y = cvt_pk_bf16(a0[2], a0[3]); w1[kq].x = cvt_pk_bf16(a1[0], a1[1]); w1[kq].y = cvt_pk_bf16(a1[2], a1[3]); }
                    const int eo = kp * 32 + (fq & 1) * 16 + (fq >> 1) * 8;
                    *(u32x4*)(KV + (size_t)u * 32768 + (size_t)((2 * wave) * 16 + fr) * 128 + eo) = pair16(w0[0], w0[1]);
                    *(u32x4*)(KV + (size_t)u * 32768 + (size_t)((2 * wave + 1) * 16 + fr) * 128 + eo) = pair16(w1[0], w1[1]); }
                __syncthreads();
            }
#undef GLA_A_PREFETCH
        }
        { const int gwp = bx * 8 + wave; constexpr int NWP = GA * 8;
          for (int g = 0; g < 4; ++g)
            for (int tp = gwp; tp < 8192; tp += 2 * NWP) { const int tpB = tp + NWP; const bool hasB = tpB < 8192;
                const int tA = 2 * tp + (lane >> 5), tB = 2 * tpB + (lane >> 5), c = g * 256 + (lane & 31) * 8;
                if (g == 0) pool_elem<2>(PN, p.pool_scale, MIX, tA, tB, hasB, c);
                else if (g == 1) pool_elem<4>(PN, p.pool_scale, MIX, tA, tB, hasB, c);
                else if (g == 2) pool_elem<8>(PN, p.pool_scale, MIX, tA, tB, hasB, c);
                else pool_elem<16>(PN, p.pool_scale, MIX, tA, tB, hasB, c); } }
    }
    GRID_SYNC();
    {
        int t5 = threadIdx.x; asm volatile("" : "+v"(t5));
        if (bx < 128) {
            const int e = bx * NTHR + t5; const int bh = e >> 13, qd = e & 8191; const int b = bh >> 2, h = bh & 3; const int k = 4 * (qd & 31);
            f32x4 st = {0.f, 0.f, 0.f, 0.f};
            for (int c0 = 0; c0 < 128; c0 += 16) {
                u32x2 kvw[16]; f32x4 gm[16];
#pragma unroll
                for (int q = 0; q < 16; ++q) { const size_t u = (size_t)((b * 128 + c0 + q) * 4 + h); kvw[q] = *(const u32x2*)(KV + u * 32768 + 4 * qd); gm[q] = *(const f32x4*)(BEND + u * 128 + k); }
#pragma unroll
                for (int q = 0; q < 16; ++q) { const size_t u = (size_t)((b * 128 + c0 + q) * 4 + h);
                    st[0] = __expf(gm[q][0]) * st[0] + bf_lo(kvw[q].x); st[1] = __expf(gm[q][1]) * st[1] + bf_hi(kvw[q].x);
                    st[2] = __expf(gm[q][2]) * st[2] + bf_lo(kvw[q].y); st[3] = __expf(gm[q][3]) * st[3] + bf_hi(kvw[q].y);
                    u32x2 o; o.x = cvt_pk_bf16(st[0], st[1]); o.y = cvt_pk_bf16(st[2], st[3]);
                    *(u32x2*)(KV + u * 32768 + 4 * qd) = o; }
            }
        }
        { pg8::WqKOrder S{bx - 128, (const char*)MEMK, (const char*)WQ}; pg8::EpiTile E{WQK, (size_t)1024}; pg8::gemm_phase<true>(lds, 512, D, 512, S, E); }
        { pg8::VWoOrder S{bx - 192, (const char*)WO, (const char*)MEMVT}; pg8::EpiTile E{VWOT, (size_t)D}; pg8::gemm_phase<true>(lds, D, 512, 512, S, E); }
    }
    GRID_SYNC();
    {
        LAS float* exch = (LAS float*)lds;
        f32x4 hn[8];
#pragma unroll
        for (int vb = 0; vb < 8; ++vb) hn[vb] = *(const f32x4*)(p.gla_head_norm + (bx & 3) * 256 + (wave >> 2) * 128 + vb * 16 + 4 * fq);
        for (int u = bx; u < 1024; u += G) {
            const int h = u & 3, chunk = u >> 2; const int t0 = chunk * 64; const int tb = wave & 3, vh = wave >> 2; const int t = t0 + tb * 16 + fr;
            u32x2 gt[8];
#pragma unroll
            for (int vb = 0; vb < 8; ++vb) gt[vb] = *(const u32x2*)(PN + (size_t)t * 4096 + 3072 + h * 256 + vh * 128 + vb * 16 + 4 * fq);
            bf16x8 qf[4];
#pragma unroll
            for (int ks = 0; ks < 4; ++ks) qf[ks] = *(const bf16x8*)(PN + (size_t)t * 4096 + 1024 + h * 128 + ks * 32 + fq * 8);
            f32x4 acc[8]; float ssq = 0.f;
#pragma unroll
            for (int vb = 0; vb < 8; ++vb) { f32x4 a = {0.f, 0.f, 0.f, 0.f};
#pragma unroll
                for (int ks = 0; ks < 4; ++ks) { const bf16x8 sf = *(const bf16x8*)(KV + (size_t)u * 32768 + (size_t)((vh * 8 + vb) * 16 + fr) * 128 + ks * 32 + fq * 8); a = __builtin_amdgcn_mfma_f32_16x16x32_bf16(sf, qf[ks], a, 0, 0, 0); }
                a = a * 0.08838834764f; acc[vb] = a; ssq += (a[0] * a[0] + a[1] * a[1]) + (a[2] * a[2] + a[3] * a[3]); }
            ssq += __shfl_xor(ssq, 16); ssq += __shfl_xor(ssq, 32);
            if (fq == 0) exch[(vh * 4 + tb) * 16 + fr] = ssq;
            __syncthreads();
            const float tot = exch[tb * 16 + fr] + exch[(4 + tb) * 16 + fr]; const float rs = rsqrtf(tot * (1.0f / 256.0f) + EPS);
#pragma unroll
            for (int vp = 0; vp < 4; ++vp) { u32x2 w2[2];
#pragma unroll
                for (int vq = 0; vq < 2; ++vq) { const int vb = 2 * vp + vq; const u32x2 gw2 = gt[vb];
                    const f32x4 o = acc[vb] * rs * hn[vb]; w2[vq].x = cvt_pk_bf16(o[0] * silu_f(bf_lo(gw2.x)), o[1] * silu_f(bf_hi(gw2.x))); w2[vq].y = cvt_pk_bf16(o[2] * silu_f(bf_lo(gw2.y)), o[3] * silu_f(bf_hi(gw2.y))); }
                const int cm = 1024 + h * 256 + vh * 128 + vp * 32 + (fq & 1) * 16 + (fq >> 1) * 8;
                *(u32x4*)(MIX + ((size_t)(cm >> 6) * T + t) * 64 + (cm & 63)) = pair16(w2[0], w2[1]); }
            __syncthreads();
        }
    }
    GRID_SYNC();
    { pg8::StdOrder S; S.init(T, D, G, bx, MIX, 64, WOUT, 64); pg8::EpiResid E{H, p.mix_norm, nullptr, p.xattn_norm, SS + 32 * T, 1.0f}; pg8::gemm_phase<true>(lds, 64, 64, D, S, E, (size_t)T * 64 * 2, (size_t)D * 64 * 2); }
    GRID_SYNC();
    { pg8::LogitOrder S{bx, (const char*)H, (const char*)WQK}; pg8::EpiSoftmax E{PATT, SS + 32 * T}; pg8::gemm_phase<false>(lds, 64, 64, D, S, E, (size_t)T * 64 * 2, (size_t)1024 * 64 * 2); }
    GRID_SYNC();
    { pg8::StdOrder S; S.init(T, D, G, bx, PATT, 64, VWOT, 64); S.bbatch = (size_t)D * 1024 * 2; pg8::EpiResid E{H, p.xattn_norm, nullptr, p.ffn2_norm, SS + 64 * T, 1.0f}; pg8::gemm_phase<true>(lds, 64, 64, 1024, S, E, (size_t)T * 64 * 2, (size_t)D * 64 * 2); }
    GRID_SYNC();
    { pg8::StdOrder S; S.init(T, 2 * FF, G, bx, H, 64, W2GU, 64); pg8::EpiSwiglu E{ACT, SS + 64 * T}; pg8::gemm_phase<true>(lds, 64, 64, D, S, E, (size_t)T * 64 * 2, (size_t)2 * FF * 64 * 2); }
    GRID_SYNC();
    { pg8::StdOrder S; S.init(T, D, G, bx, ACT, 64, W2D, 64); S.wgm = 4; pg8::EpiResid E{H, p.ffn2_norm, nullptr, p.final_norm, SS + 96 * T, 0.5f};   pg8::gemm_phase<true>(lds, 64, 64, FF, S, E, (size_t)T * 64 * 2, (size_t)D * 64 * 2); }
    GRID_SYNC();
    { int t14 = threadIdx.x; asm volatile("" : "+v"(t14)); const int l14 = t14 & 63, gw14 = blockIdx.x * 8 + (t14 >> 6);
      const float* ss3 = SS + 96 * T;
      for (int m = gw14; m < T; m += NGW) {
          const float part = (l14 < 32) ? ss3[(size_t)m * 32 + l14] : 0.f; const float rs = rsqrtf(wave_sum(part) * (1.0f / 2048.0f) + EPS);
#pragma unroll
          for (int j4 = 0; j4 < 4; ++j4) { const int col = (l14 + 64 * j4) * 8; const u32x4 w = *(const u32x4*)(H + ((size_t)(col >> 6) * T + m) * 64 + (col & 63));
              f32x4 a, b; a[0] = bf_lo(w.x) * rs; a[1] = bf_hi(w.x) * rs; a[2] = bf_lo(w.y) * rs; a[3] = bf_hi(w.y) * rs; b[0] = bf_lo(w.z) * rs; b[1] = bf_hi(w.z) * rs; b[2] = bf_lo(w.w) * rs; b[3] = bf_hi(w.w) * rs;
              *(f32x4*)(p.out + (size_t)m * D + col) = a; *(f32x4*)(p.out + (size_t)m * D + col + 4) = b; } } }
}

extern "C" void kernel_launch(void* const* d_in, const int* in_sizes, int n_in, void* d_out, int out_size, void* d_ws, size_t ws_size, hipStream_t stream) {
    static int grid = 0;
    if (grid == 0) {
        if (n_in != 24 || out_size != T * D || ws_size < WS_END) { fprintf(stderr, "kernel_launch: unexpected shapes n_in %d out %d ws %zu (need %zu)\n", n_in, out_size, ws_size, (size_t)WS_END); grid = -1; return; }
        int dev = 0, cus = 0, per_cu = 0;
        (void)hipGetDevice(&dev); (void)hipDeviceGetAttribute(&cus, hipDeviceAttributeMultiprocessorCount, dev);
        (void)hipFuncSetAttribute((const void*)fwd_megakernel, hipFuncAttributeMaxDynamicSharedMemorySize, LDS_BYTES);
        (void)hipOccupancyMaxActiveBlocksPerMultiprocessor(&per_cu, (const void*)fwd_megakernel, NTHR, LDS_BYTES);
        (void)hipGetLastError();
        grid = cus < NWG ? cus : NWG;
        if (per_cu < 1) fprintf(stderr, "kernel_launch: occupancy query says %d blocks/CU\n", per_cu);
    }
    if (grid < 0) return;
    if (hipMemsetAsync((char*)d_ws + WS_BAR, 0, 16384, stream) != hipSuccess) { fprintf(stderr, "kernel_launch: memset failed\n"); return; }
    Params p{};
    const float** pp = (const float**)&p;
    for (int i = 0; i < 24; ++i) pp[i] = (const float*)d_in[i];
    p.out = (float*)d_out; p.ws = (unsigned char*)d_ws;
    void* args[] = {&p};
    hipError_t e = hipLaunchCooperativeKernel((const void*)fwd_megakernel, dim3(grid), dim3(NTHR), args, LDS_BYTES, stream);
    if (e != hipSuccess) fprintf(stderr, "cooperative launch failed: %s (grid %d)\n", hipGetErrorString(e), grid);
}
```

```cpp
#include <hip/hip_runtime.h>
#include <hip/hip_cooperative_groups.h>
#include <cstdio>
#include <cstdint>
namespace cg = cooperative_groups;

#define LAS __attribute__((address_space(3)))
typedef unsigned short bf16_t;
typedef short bf16x8 __attribute__((ext_vector_type(8)));
typedef float f32x4 __attribute__((ext_vector_type(4)));
typedef float f32x2 __attribute__((ext_vector_type(2)));
typedef unsigned u32x4 __attribute__((ext_vector_type(4)));
typedef unsigned u32x2 __attribute__((ext_vector_type(2)));

constexpr int T = 16384, D = 2048, FF = 5632, SEQ = 8192, MEMT = 512;
constexpr int NWG = 256, NTHR = 512;
constexpr float EPS = 1e-6f;

constexpr size_t WS_BAR   = 0;
constexpr size_t WS_SS    = 16384;
constexpr size_t WS_ALR   = WS_SS + 4ull * T * 32 * 4;
constexpr size_t WS_BEND  = WS_ALR + (size_t)T * 16 * 4;
constexpr size_t WS_MEMH  = WS_BEND + 1024ull * 128 * 4;
constexpr size_t WS_MEMK  = WS_MEMH + (size_t)MEMT * D * 2;
constexpr size_t WS_MEMVT = WS_MEMK + (size_t)MEMT * D * 2;
constexpr size_t WS_W1GU  = WS_MEMVT + (size_t)MEMT * D * 2;
constexpr size_t WS_W1D   = WS_W1GU + 2ull * FF * D * 2;
constexpr size_t WS_W2GU  = WS_W1D + (size_t)FF * D * 2;
constexpr size_t WS_W2D   = WS_W2GU + 2ull * FF * D * 2;
constexpr size_t WS_WIN   = WS_W2D + (size_t)FF * D * 2;
constexpr size_t WS_WA    = WS_WIN + 4096ull * D * 2;
constexpr size_t WS_POOLW = WS_WA + 16ull * D * 2;
constexpr size_t WS_WOUT  = WS_POOLW + 4ull * 256 * 256 * 2;
constexpr size_t WS_WQ    = WS_WOUT + (size_t)D * D * 2;
constexpr size_t WS_WKV   = WS_WQ + (size_t)D * D * 2;
constexpr size_t WS_WO    = WS_WKV + 2ull * D * D * 2;
constexpr size_t WS_H     = WS_WO + (size_t)D * D * 2;
constexpr size_t WS_ACT   = WS_H + (size_t)T * D * 2;
constexpr size_t WS_MIX   = WS_ACT + (size_t)T * FF * 2;
constexpr size_t WS_RS0   = WS_MIX + (size_t)T * D * 2;
constexpr size_t WS_END   = WS_RS0 + (size_t)T * 4;
constexpr size_t ACT_KT   = (size_t)T * 4096 * 2;
constexpr size_t ACT_VT   = ACT_KT + 1024ull * 8192 * 2;
constexpr size_t ACT_PATT = (size_t)T * D * 2;
constexpr size_t ACT_WQK  = ACT_KT;
constexpr size_t ACT_VWOT = ACT_WQK + 2ull * 1024 * D * 2;

constexpr int LDS_BYTES = 139264;

typedef __bf16 bf16x2_t __attribute__((ext_vector_type(2)));
__device__ __forceinline__ unsigned cvt_pk_bf16(float lo, float hi) { const f32x2 v = {lo, hi}; const bf16x2_t r = __builtin_convertvector(v, bf16x2_t); return __builtin_bit_cast(unsigned, r); }
__device__ __forceinline__ u32x4 pair16(u32x2 a, u32x2 b) {
    const auto rx = __builtin_amdgcn_permlane16_swap(a.x, b.x, false, false); const auto ry = __builtin_amdgcn_permlane16_swap(a.y, b.y, false, false);
    return (u32x4){rx[0], ry[0], rx[1], ry[1]};
}
template <int CTRL> __device__ __forceinline__ unsigned dpp_quad(unsigned x) { return (unsigned)__builtin_amdgcn_mov_dpp((int)x, CTRL, 0xf, 0xf, true); }
__device__ __forceinline__ float bf_lo(unsigned w) { return __uint_as_float(w << 16); }
__device__ __forceinline__ float bf_hi(unsigned w) { return __uint_as_float(w & 0xffff0000u); }
__device__ __forceinline__ float silu_f(float g) { return g * __builtin_amdgcn_rcpf(1.0f + __builtin_amdgcn_exp2f(-1.44269504f * g)); }
__device__ __forceinline__ float rstd_of(const float* ss, int row) {
    const f32x4* q = (const f32x4*)(ss + (size_t)row * 32); float s = 0.f;
#pragma unroll
    for (int j = 0; j < 8; ++j) { const f32x4 v = q[j]; s += (v[0] + v[1]) + (v[2] + v[3]); }
    return rsqrtf(s * (1.0f / 2048.0f) + EPS); }

struct RowScale { const float* ss; const LAS float* rsl; int pm0; };
__device__ __forceinline__ float row_rs(const RowScale& R, int pm, int lr) { return (R.rsl && pm == R.pm0) ? R.rsl[lr] : rstd_of(R.ss, pm * 256 + lr); }
__device__ __forceinline__ void fill_rsl(LAS float* rsl, const float* ss, int pm) { if (threadIdx.x < 256) rsl[threadIdx.x] = rstd_of(ss, pm * 256 + (int)threadIdx.x); __syncthreads(); }

namespace pg8 {
constexpr int BM = 256, BK = 64, HALF = 128, HTB = HALF * BK * 2, STAGE_BYTES = 8 * HTB, NXCD = 8, WGM = 8;
__device__ __forceinline__ int lds_byte(int r, int c) { const int st = (r >> 4) * 2 + (c >> 5), rr = r & 15, cc = c & 31, ob = rr * 64 + cc * 2; return st * 1024 + (ob ^ (((ob >> 9) & 1) << 5)); }
__device__ __forceinline__ void stage_rc(int b, int& R, int& C) { const int st = b / 1024, sb = b % 1024, swz = sb ^ (((sb >> 9) & 1) << 5); R = (st >> 1) * 16 + swz / 64; C = (st & 1) * 32 + (swz % 64) / 2; }
__device__ __forceinline__ int perm32(int rho) { const int n = rho >> 4, i = rho & 15; return 8 * (i >> 2) + 4 * n + (i & 3); }

struct Unit { int pm, pn, z; const char* a; const char* b; size_t o; int r0, c0; };

struct StdOrder {
    int nM, nN, nwg, G, c, wgm; const char* A; const char* B; size_t ta, tb, bbatch;
    __device__ void init(int M, int N, int G_, int c_, const void* A_, size_t lda, const void* B_, size_t ldb) { nM = M / BM; nN = N / BM; nwg = nM * nN; G = G_; c = c_; A = (const char*)A_; B = (const char*)B_; ta = (size_t)BM * lda * 2; tb = (size_t)BM * ldb * 2; bbatch = 0; wgm = WGM; }
    __device__ bool next(int i, Unit& u) const {
        const long L = (long)i * G + c; if (c >= G || L >= nwg) return false;
        int wgid = (int)L; { const int q = nwg / NXCD, r = nwg % NXCD, xcd = wgid % NXCD, off = wgid / NXCD; wgid = (xcd < r ? xcd * (q + 1) : r * (q + 1) + (xcd - r) * q) + off; }
        const int nig = wgm * nN, gid = wgid / nig, fm = gid * wgm, gsz = (nM - fm) < wgm ? (nM - fm) : wgm;
        u.pm = fm + ((wgid % nig) % gsz); u.pn = (wgid % nig) / gsz; u.z = 0; u.o = 0; u.r0 = 0; u.c0 = 0; u.a = A + (size_t)u.pm * ta; u.b = B + (size_t)u.pn * tb + ((u.pm >= (nM >> 1)) ? bbatch : (size_t)0); return true;
    }
};

template <bool ALIGN_EPI, class Epi, class Sched>
__device__ __forceinline__ void gemm_phase(LAS unsigned char* lds, const int lda, const int ldb, const int K, const Sched& S, const Epi& E, const size_t kstepA = (size_t)(BK * 2), const size_t kstepB = (size_t)(BK * 2)) {
    int tid = threadIdx.x; asm volatile("" : "+v"(tid));
    const int wid = __builtin_amdgcn_readfirstlane(tid >> 6), lane = tid & 63, wr = wid >> 2, wc = wid & 3, fr = lane & 15, fq = lane >> 4;
    const int nt = K / BK;
    unsigned voffA[2], voffB[2];
#pragma unroll
    for (int i = 0; i < 2; ++i) { int R, C; stage_rc(tid * 16 + i * 8192, R, C); const int Rb = (R & ~31) + perm32(R & 31);
        voffA[i] = (unsigned)(R * lda + C) * 2u; voffB[i] = (unsigned)(Rb * ldb + C) * 2u; }
    const size_t kstep = kstepB;
    const size_t hstepA = (size_t)HALF * lda * 2, hstepB = (size_t)HALF * ldb * 2;
    const unsigned ldsw = (unsigned)wid * 1024u;
    const int aoff = lds_byte(wr * 64 + fr, fq * 8), boff = lds_byte(wc * 32 + fr, fq * 8);
#define PG8_SA(b, h) (((b) * 2 + (h)) * HTB)
#define PG8_SB(b, h) ((4 + (b) * 2 + (h)) * HTB)
#define PG8_STAGE(bufoff, gbase, voff) do { _Pragma("unroll") for (int _i = 0; _i < 2; ++_i) \
        __builtin_amdgcn_global_load_lds((const unsigned*)((const char*)(gbase) + (voff)[_i]), (LAS unsigned*)(lds + (bufoff) + ldsw + _i * 8192), 16, 0, 0); } while (0)
#define PG8_LDA(dst, b, h) do { _Pragma("unroll") for (int m = 0; m < 4; ++m) _Pragma("unroll") for (int k = 0; k < 2; ++k) dst[m][k] = *(const LAS bf16x8*)(lds + PG8_SA(b, h) + aoff + m * 2048 + k * 1024); } while (0)
#define PG8_LDB(dst, b, h) do { _Pragma("unroll") for (int n = 0; n < 2; ++n) _Pragma("unroll") for (int k = 0; k < 2; ++k) dst[n][k] = *(const LAS bf16x8*)(lds + PG8_SB(b, h) + boff + n * 2048 + k * 1024); } while (0)
#define PG8_MMA(ai, bj, At, Bt) do { __builtin_amdgcn_s_setprio(1); _Pragma("unroll") for (int m = 0; m < 4; ++m) _Pragma("unroll") for (int n = 0; n < 2; ++n) _Pragma("unroll") for (int k = 0; k < 2; ++k) \
        acc[ai][bj][m][n] = __builtin_amdgcn_mfma_f32_16x16x32_bf16(Bt[n][k], At[m][k], acc[ai][bj][m][n], 0, 0, 0); __builtin_amdgcn_s_setprio(0); } while (0)
#define PG8_WAIT_V(n) asm volatile("s_waitcnt vmcnt(" #n ")" ::: "memory")
#define PG8_WAIT_L(n) asm volatile("s_waitcnt lgkmcnt(" #n ")" ::: "memory")
#define PG8_BAR __builtin_amdgcn_s_barrier()
#define PG8_SCHED __builtin_amdgcn_sched_barrier(0)
    Unit cur, nxt; int ui = 0;
    if (!S.next(0, cur)) return;
    f32x4 acc[2][2][4][2];
#pragma unroll
    for (int a = 0; a < 2; ++a)
#pragma unroll
        for (int b = 0; b < 2; ++b)
#pragma unroll
            for (int m = 0; m < 4; ++m)
#pragma unroll
                for (int n = 0; n < 2; ++n) acc[a][b][m][n] = (f32x4){0.f, 0.f, 0.f, 0.f};
    bf16x8 At[4][2], B0[2][2], B1[2][2];
    const char* cA = cur.a; const char* cB = cur.b;
    PG8_STAGE(PG8_SB(0, 0), cB, voffB); PG8_STAGE(PG8_SB(0, 1), cB + hstepB, voffB); PG8_STAGE(PG8_SA(0, 0), cA, voffA); PG8_STAGE(PG8_SA(0, 1), cA + hstepA, voffA);
    if (wr == 1) PG8_BAR;
    PG8_WAIT_V(2); PG8_BAR;
    PG8_STAGE(PG8_SB(1, 0), cB + kstep, voffB); PG8_STAGE(PG8_SA(1, 0), cA + kstepA, voffA); PG8_STAGE(PG8_SB(1, 1), cB + hstepB + kstep, voffB);
    PG8_WAIT_V(6); PG8_BAR;
    for (;;) {
        const bool has_next = S.next(ui + 1, nxt);
        const char* nA = has_next ? nxt.a : cA; const char* nB = has_next ? nxt.b : cB;
#pragma unroll 1
        for (int t = 0; t < nt; t += 2) {
            const bool last = (t == nt - 2);
            const char* a1 = cA + (size_t)(t + 1) * kstepA;
            const char* a2 = last ? nA : cA + (size_t)(t + 2) * kstepA; const char* b2 = last ? nB : cB + (size_t)(t + 2) * kstep;
            const char* a3 = a2 + kstepA; const char* b3 = b2 + kstep;
            PG8_LDB(B0, 0, 0); PG8_LDB(B1, 0, 1); PG8_SCHED; PG8_LDA(At, 0, 0); PG8_STAGE(PG8_SA(1, 1), a1 + hstepA, voffA);
            PG8_WAIT_V(8); PG8_WAIT_L(0); PG8_BAR; PG8_MMA(0, 0, At, B0); PG8_MMA(0, 1, At, B1); PG8_BAR; PG8_SCHED;
            PG8_LDA(At, 0, 1); PG8_STAGE(PG8_SB(0, 0), b2, voffB); PG8_STAGE(PG8_SB(0, 1), b2 + hstepB, voffB); PG8_STAGE(PG8_SA(0, 0), a2, voffA);
            PG8_WAIT_V(8); PG8_WAIT_L(0); PG8_BAR; PG8_MMA(1, 0, At, B0); PG8_MMA(1, 1, At, B1); PG8_BAR; PG8_SCHED;
            PG8_LDB(B0, 1, 0); PG8_LDB(B1, 1, 1); PG8_SCHED; PG8_LDA(At, 1, 0); PG8_STAGE(PG8_SA(0, 1), a2 + hstepA, voffA);
            PG8_WAIT_V(8); PG8_WAIT_L(0); PG8_BAR; PG8_MMA(0, 0, At, B0); PG8_MMA(0, 1, At, B1); PG8_BAR; PG8_SCHED;
            PG8_LDA(At, 1, 1); PG8_STAGE(PG8_SB(1, 0), b3, voffB); PG8_STAGE(PG8_SB(1, 1), b3 + hstepB, voffB); PG8_STAGE(PG8_SA(1, 0), a3, voffA);
            PG8_WAIT_V(8); PG8_WAIT_L(0); PG8_BAR; PG8_MMA(1, 0, At, B0); PG8_MMA(1, 1, At, B1); PG8_BAR; PG8_SCHED;
        }
        if constexpr (ALIGN_EPI) { if (wr == 0) PG8_BAR; }
        if constexpr (!Epi::AFTER_DRAIN) { E(acc, cur, wr, wc, fr, fq); }
        if (!has_next) break;
#pragma unroll
        for (int a = 0; a < 2; ++a)
#pragma unroll
            for (int b = 0; b < 2; ++b)
#pragma unroll
                for (int m = 0; m < 4; ++m)
#pragma unroll
                    for (int n = 0; n < 2; ++n) acc[a][b][m][n] = (f32x4){0.f, 0.f, 0.f, 0.f};
        cur = nxt; cA = nA; cB = nB; ++ui;
        if constexpr (ALIGN_EPI) { if (wr == 1) PG8_BAR; }
    }
    PG8_WAIT_V(0);
    if constexpr (!ALIGN_EPI) { if (wr == 0) PG8_BAR; }
    PG8_BAR;
    if constexpr (Epi::AFTER_DRAIN) { E.fused(acc, cur, wr, wc, fr, fq, lds, wid, lane); }
#undef PG8_SA
#undef PG8_SB
#undef PG8_STAGE
#undef PG8_LDA
#undef PG8_LDB
#undef PG8_MMA
#undef PG8_WAIT_V
#undef PG8_WAIT_L
#undef PG8_BAR
#undef PG8_SCHED
}

typedef f32x4 Acc[2][2][4][2];

struct EpiSwiglu {
    static constexpr bool AFTER_DRAIN = false;
    bf16_t* O; bool scaled; RowScale R;
    __device__ __forceinline__ void operator()(const Acc& acc, const Unit& u, int wr, int wc, int fr, int fq) const {
        const int row0 = u.pm * BM + wr * 64 + fr, col0 = u.pn * 128 + wc * 32 + 8 * fq;
#pragma unroll
        for (int ai = 0; ai < 2; ++ai)
#pragma unroll
            for (int m = 0; m < 4; ++m) { const int row = row0 + ai * HALF + m * 16; const float rs = scaled ? row_rs(R, u.pm, ai * HALF + wr * 64 + m * 16 + fr) : 1.0f;
                const f32x4 g0 = acc[ai][0][m][0] * rs, g1 = acc[ai][0][m][1] * rs, u0 = acc[ai][1][m][0] * rs, u1 = acc[ai][1][m][1] * rs;
                u32x4 w; w.x = cvt_pk_bf16(silu_f(g0[0]) * u0[0], silu_f(g0[1]) * u0[1]); w.y = cvt_pk_bf16(silu_f(g0[2]) * u0[2], silu_f(g0[3]) * u0[3]);
                w.z = cvt_pk_bf16(silu_f(g1[0]) * u1[0], silu_f(g1[1]) * u1[1]); w.w = cvt_pk_bf16(silu_f(g1[2]) * u1[2], silu_f(g1[3]) * u1[3]);
                *(u32x4*)(O + ((size_t)(col0 >> 6) * T + row) * 64 + (col0 & 63)) = w; }
    }
};
struct EpiResid {
    static constexpr bool AFTER_DRAIN = false;
    bf16_t* xs; const float* gprev; const float* rsprev; const float* gain; float* ss; float alpha;
    __device__ __forceinline__ void operator()(const Acc& acc, const Unit& u, int wr, int wc, int fr, int fq) const {
        const int row0 = u.pm * BM + wr * 64 + fr, col0 = u.pn * BM + wc * 32 + 8 * fq;
        f32x4 gv[2][2], gi[2][2];
#pragma unroll
        for (int bj = 0; bj < 2; ++bj)
#pragma unroll
            for (int n = 0; n < 2; ++n) { gv[bj][n] = *(const f32x4*)(gain + col0 + bj * HALF + 4 * n); const f32x4 gp = *(const f32x4*)(gprev + col0 + bj * HALF + 4 * n);
                gi[bj][n] = (f32x4){1.0f / gp[0], 1.0f / gp[1], 1.0f / gp[2], 1.0f / gp[3]}; }
#pragma unroll
        for (int ai = 0; ai < 2; ++ai) {
            u32x4 pv[4][2]; float rinv[4];
#pragma unroll
            for (int m = 0; m < 4; ++m) { const int row = row0 + ai * HALF + m * 16; rinv[m] = rsprev ? rsprev[row] : 1.0f;
#pragma unroll
                for (int bj = 0; bj < 2; ++bj) { const int cx = col0 + bj * HALF; pv[m][bj] = *(const u32x4*)(xs + ((size_t)(cx >> 6) * T + row) * 64 + (cx & 63)); } }
#pragma unroll
            for (int m = 0; m < 4; ++m) { const int row = row0 + ai * HALF + m * 16; const float ri = rsprev ? 1.0f / rinv[m] : 1.0f; float s = 0.f;
#pragma unroll
                for (int bj = 0; bj < 2; ++bj) { const int cx = col0 + bj * HALF; bf16_t* px = xs + ((size_t)(cx >> 6) * T + row) * 64 + (cx & 63); const u32x4 pw = pv[m][bj];
                    const f32x4 x0 = (f32x4){bf_lo(pw.x), bf_hi(pw.x), bf_lo(pw.y), bf_hi(pw.y)} * gi[bj][0] * ri, x1 = (f32x4){bf_lo(pw.z), bf_hi(pw.z), bf_lo(pw.w), bf_hi(pw.w)} * gi[bj][1] * ri;
                    const f32x4 y0 = x0 + acc[ai][bj][m][0] * alpha, y1 = x1 + acc[ai][bj][m][1] * alpha;
                    s += (y0[0] * y0[0] + y0[1] * y0[1]) + (y0[2] * y0[2] + y0[3] * y0[3]) + (y1[0] * y1[0] + y1[1] * y1[1]) + (y1[2] * y1[2] + y1[3] * y1[3]);
                    const f32x4 a = y0 * gv[bj][0], b = y1 * gv[bj][1]; u32x4 w; w.x = cvt_pk_bf16(a[0], a[1]); w.y = cvt_pk_bf16(a[2], a[3]); w.z = cvt_pk_bf16(b[0], b[1]); w.w = cvt_pk_bf16(b[2], b[3]);
                    *(u32x4*)px = w; }
                s += __shfl_xor(s, 16); s += __shfl_xor(s, 32);
                if (fq == 0) ss[(size_t)row * 32 + u.pn * 4 + wc] = s; }
            asm volatile("" ::: "memory"); }
    }
};
__device__ __forceinline__ void store_nat(const Acc& acc, bf16_t* base, size_t ldc, int row0, int col0, const float* ss, const RowScale* R = nullptr, int pm = 0) {
#pragma unroll
    for (int ai = 0; ai < 2; ++ai)
#pragma unroll
        for (int m = 0; m < 4; ++m) { const int row = row0 + ai * HALF + m * 16; const float rs = R ? row_rs(*R, pm, row - pm * 256) : (ss ? rstd_of(ss, row) : 1.0f);
#pragma unroll
            for (int bj = 0; bj < 2; ++bj) { const f32x4 a = acc[ai][bj][m][0] * rs, b = acc[ai][bj][m][1] * rs; u32x4 w; w.x = cvt_pk_bf16(a[0], a[1]); w.y = cvt_pk_bf16(a[2], a[3]); w.z = cvt_pk_bf16(b[0], b[1]); w.w = cvt_pk_bf16(b[2], b[3]);
                *(u32x4*)(base + (size_t)row * ldc + col0 + bj * HALF) = w; } }
}
struct EpiWin {
    static constexpr bool AFTER_DRAIN = false;
    bf16_t* P; bf16_t* KT; bf16_t* VT; RowScale R;
    __device__ __forceinline__ void operator()(const Acc& acc, const Unit& u, int wr, int wc, int fr, int fq) const {
        const int row0 = u.pm * BM + wr * 64 + fr;
        if (u.pn < 6 || u.pn >= 12) { store_nat(acc, P, 4096, row0, u.pn * BM + wc * 32 + 8 * fq, nullptr, &R, u.pm); return; }
        const bool isk = u.pn < 8;
#pragma unroll
        for (int ai = 0; ai < 2; ++ai) { const int chunk = u.pm * 4 + ai * 2 + wr;
#pragma unroll
            for (int m = 0; m < 4; ++m) { const float rs = row_rs(R, u.pm, ai * HALF + wr * 64 + m * 16 + fr); const int i = m * 16 + fr;
#pragma unroll
                for (int bj = 0; bj < 2; ++bj)
#pragma unroll
                    for (int n = 0; n < 2; ++n) { const f32x4 a = acc[ai][bj][m][n] * rs; const int c = bj * HALF + wc * 32 + 8 * fq + 4 * n;
                        const unsigned p0 = cvt_pk_bf16(a[0], a[1]), p1 = cvt_pk_bf16(a[2], a[3]);
                        const int t4 = fr & 3; const bool odd = (t4 & 1) != 0, hi2 = (t4 & 2) != 0;
                        const unsigned own1 = odd ? p1 : p0, rcv1 = dpp_quad<0xB1>(odd ? p0 : p1);
                        const unsigned first = odd ? rcv1 : own1, second = odd ? own1 : rcv1;
                        const unsigned qa = (first & 0xffffu) | (second << 16), qb = (first >> 16) | (second & 0xffff0000u);
                        const unsigned own2 = hi2 ? qb : qa, rcv2 = dpp_quad<0x4E>(hi2 ? qa : qb);
                        u32x2 w; w.x = hi2 ? rcv2 : own2; w.y = hi2 ? own2 : rcv2;
                        const int cf = c + (((t4 & 1) << 1) | (t4 >> 1)), i4 = i & ~3;
                        bf16_t* dst;
                        if (isk) { const int kf = (u.pn - 6) * 256 + cf; dst = KT + ((size_t)(chunk * 4 + (kf >> 7)) * 8192 + (size_t)(kf & 127) * 64 + i4); }
                        else { dst = VT + ((size_t)(chunk * 4 + (u.pn - 8)) * 16384 + (size_t)cf * 64 + i4); }
                        *(u32x2*)dst = w; } } }
    }
};
struct EpiMemKV {
    static constexpr bool AFTER_DRAIN = false;
    bf16_t* MK; bf16_t* MV;
    __device__ __forceinline__ void operator()(const Acc& acc, const Unit& u, int wr, int wc, int fr, int fq) const {
        const int h = (u.pn & 7) >> 1, d0 = (u.pn & 1) * 256; bf16_t* base = (u.pn < 8 ? MK : MV) + (size_t)(u.pm * 4 + h) * 256 * 512;
        store_nat(acc, base, 512, wr * 64 + fr, d0 + wc * 32 + 8 * fq, nullptr);
    }
};
struct EpiTile {
    static constexpr bool AFTER_DRAIN = false;
    bf16_t* O; size_t NR;
    __device__ __forceinline__ void operator()(const Acc& acc, const Unit& u, int wr, int wc, int fr, int fq) const {
        bf16_t* base = O + u.o;
#pragma unroll
        for (int ai = 0; ai < 2; ++ai)
#pragma unroll
            for (int m = 0; m < 4; ++m) { const int row = u.r0 + ai * HALF + wr * 64 + m * 16 + fr;
#pragma unroll
                for (int bj = 0; bj < 2; ++bj) { const int col = u.c0 + bj * HALF + wc * 32 + 8 * fq; const f32x4 a = acc[ai][bj][m][0], b = acc[ai][bj][m][1];
                    u32x4 w; w.x = cvt_pk_bf16(a[0], a[1]); w.y = cvt_pk_bf16(a[2], a[3]); w.z = cvt_pk_bf16(b[0], b[1]); w.w = cvt_pk_bf16(b[2], b[3]);
                    *(u32x4*)(base + ((size_t)(col >> 6) * NR + row) * 64 + (col & 63)) = w; } }
    }
};
struct EpiSoftmax {
    static constexpr bool AFTER_DRAIN = true;
    bf16_t* Pout; RowScale R;
    __device__ __forceinline__ void operator()(const Acc&, const Unit&, int, int, int, int) const {}
    __device__ __forceinline__ void fused(Acc& acc, const Unit& u, int wr, int wc, int fr, int fq, LAS unsigned char* lds, int wid, int lane) const {
        LAS float* X = (LAS float*)lds; LAS float* Y = (LAS float*)(lds + 4096);
        const float sc = 0.04419417382f * 1.44269504f;
#pragma unroll
        for (int ai = 0; ai < 2; ++ai)
#pragma unroll
            for (int m = 0; m < 4; ++m) { float mx = -3.0e38f; const float rs = row_rs(R, u.pm, ai * HALF + wr * 64 + m * 16 + fr);
#pragma unroll
                for (int bj = 0; bj < 2; ++bj)
#pragma unroll
                    for (int n = 0; n < 2; ++n) { const f32x4 a = acc[ai][bj][m][n] * rs; acc[ai][bj][m][n] = a; mx = fmaxf(mx, fmaxf(fmaxf(a[0], a[1]), fmaxf(a[2], a[3]))); }
                mx = fmaxf(mx, __shfl_xor(mx, 16)); mx = fmaxf(mx, __shfl_xor(mx, 32));
                if (fq == 0) X[(ai * HALF + wr * 64 + m * 16 + fr) * 4 + wc] = mx; }
        asm volatile("s_waitcnt lgkmcnt(0)" ::: "memory"); __builtin_amdgcn_s_barrier(); asm volatile("" ::: "memory");
#pragma unroll
        for (int ai = 0; ai < 2; ++ai)
#pragma unroll
            for (int m = 0; m < 4; ++m) { const int r = ai * HALF + wr * 64 + m * 16 + fr; const f32x4 mv = *(const LAS f32x4*)(X + r * 4);
                const float rm = fmaxf(fmaxf(mv[0], mv[1]), fmaxf(mv[2], mv[3])) * sc; float s = 0.f;
#pragma unroll
                for (int bj = 0; bj < 2; ++bj)
#pragma unroll
                    for (int n = 0; n < 2; ++n) { f32x4 a = acc[ai][bj][m][n];
#pragma unroll
                        for (int j = 0; j < 4; ++j) { a[j] = __builtin_amdgcn_exp2f(a[j] * sc - rm); s += a[j]; }
                        acc[ai][bj][m][n] = a; }
                s += __shfl_xor(s, 16); s += __shfl_xor(s, 32);
                if (fq == 0) Y[r * 4 + wc] = s; }
        asm volatile("s_waitcnt lgkmcnt(0)" ::: "memory"); __builtin_amdgcn_s_barrier(); asm volatile("" ::: "memory");
        const int row0 = u.pm * BM + wr * 64 + fr, col0 = u.z * 256 + wc * 32 + 8 * fq;
#pragma unroll
        for (int ai = 0; ai < 2; ++ai)
#pragma unroll
            for (int m = 0; m < 4; ++m) { const int r = ai * HALF + wr * 64 + m * 16 + fr; const f32x4 sv = *(const LAS f32x4*)(Y + r * 4);
                const float inv = 1.0f / ((sv[0] + sv[1]) + (sv[2] + sv[3])); const int row = row0 + ai * HALF + m * 16;
#pragma unroll
                for (int bj = 0; bj < 2; ++bj) { const f32x4 a = acc[ai][bj][m][0] * inv, b = acc[ai][bj][m][1] * inv; u32x4 w; w.x = cvt_pk_bf16(a[0], a[1]); w.y = cvt_pk_bf16(a[2], a[3]); w.z = cvt_pk_bf16(b[0], b[1]); w.w = cvt_pk_bf16(b[2], b[3]);
                    const int cp = col0 + bj * HALF; *(u32x4*)(Pout + ((size_t)(cp >> 6) * T + row) * 64 + (cp & 63)) = w; } }
    }
};
struct WinFoldOrder {
    int c; const char* PW; const char* WINU;
    __device__ bool next(int i, Unit& u) const { if (i > 0 || c < 0 || c >= 32) return false; const int g = c >> 3; u.pm = g; u.z = 0; u.pn = c & 7;
        u.a = PW + (size_t)g * 65536 * 2; u.b = WINU + ((size_t)u.pn * 256 * 1024 + g * 256) * 2; u.o = 0; u.r0 = g * 256; u.c0 = u.pn * 256; return true; }
};
struct WqKOrder {
    int c; const char* MK; const char* WQN;
    __device__ bool next(int i, Unit& u) const { if (i > 0 || c < 0 || c >= 64) return false; const int b = c >> 5, h = (c >> 3) & 3; u.pm = b; u.z = h; u.pn = c & 7;
        u.a = MK + (size_t)((b * 4 + h) * 256 * 512) * 2; u.b = WQN + ((size_t)u.pn * 256 * D + h * 512) * 2; u.o = (size_t)b * 1024 * D; u.r0 = h * 256; u.c0 = u.pn * 256; return true; }
};
struct VWoOrder {
    int c; const char* WOT; const char* MV;
    __device__ bool next(int i, Unit& u) const { if (i > 0 || c < 0 || c >= 64) return false; const int b = c >> 5, h = (c >> 3) & 3; u.pm = c & 7; u.z = h; u.pn = 0;
        u.a = WOT + ((size_t)u.pm * 256 * D + h * 512) * 2; u.b = MV + (size_t)((b * 4 + h) * 256 * 512) * 2; u.o = (size_t)b * D * 1024; u.r0 = u.pm * 256; u.c0 = h * 256; return true; }
};
struct LogitOrder {
    int c; const char* A; const char* WQK;
    __device__ bool next(int i, Unit& u) const { if (i > 0 || c >= 256) return false; const int v = (c & 7) * 32 + (c >> 3); u.pm = v >> 2; u.z = v & 3; u.pn = 0; u.o = 0;
        u.a = A + (size_t)u.pm * 256 * 64 * 2; u.b = WQK + ((size_t)(u.pm >> 5) * 1024 * D + (size_t)u.z * 256 * 64) * 2; return true; }
};
struct MemKVOrder {
    int c; const char* A; const char* B;
    __device__ bool next(int i, Unit& u) const { if (i > 0 || c >= 32 || c < 0) return false; u.pm = c & 1; u.pn = c >> 1; u.z = 0; u.o = 0; u.a = A + (size_t)u.pm * 256 * D * 2; u.b = B + (size_t)u.pn * 256 * D * 2; return true; }
};
}

struct Params {
    const float *x, *mem, *ffn1_norm, *ffn1_wg, *ffn1_wu, *ffn1_wd, *mix_norm, *w_in, *pool_w, *pool_scale, *gla_w_a2, *gla_b_a, *gla_head_norm, *w_out,
        *xattn_norm, *mem_norm, *wq, *wkv, *wo, *ffn2_norm, *ffn2_wg, *ffn2_wu, *ffn2_wd, *final_norm;
    float* out; unsigned char* ws;
};

__device__ __forceinline__ float wave_sum(float v) {
#pragma unroll
    for (int o = 1; o < 64; o <<= 1) v += __shfl_xor(v, o);
    return v;
}

__device__ __forceinline__ void conv_item(const float* W, int K, int ld, int nblk, bf16_t* WT, int mode, LAS float* scr, int item, int lane, int tiledNR = 0) {
    const int kb = item / nblk, nb = item - kb * nblk, k0 = 64 * kb, n0 = 64 * nb;
    const float* src = W + (size_t)k0 * ld + n0 + lane;
    float tv[64];
#pragma unroll
    for (int kk = 0; kk < 64; ++kk) tv[kk] = __builtin_nontemporal_load(src + (size_t)kk * ld);
#pragma unroll
    for (int kk = 0; kk < 64; ++kk) scr[kk * 65 + lane] = tv[kk];
    asm volatile("s_waitcnt lgkmcnt(0)" ::: "memory");
    const int c = lane & 7;
    const int rbase = (mode == 0) ? n0 : ((n0 >> 7) * 256 + (n0 & 127) + (mode == 2 ? 128 : 0));
#pragma unroll
    for (int j = 0; j < 8; ++j) { const int n = (lane >> 3) + 8 * j; const LAS float* s = scr + (8 * c) * 65 + n;
        u32x4 o; o.x = cvt_pk_bf16(s[0], s[65]); o.y = cvt_pk_bf16(s[2 * 65], s[3 * 65]); o.z = cvt_pk_bf16(s[4 * 65], s[5 * 65]); o.w = cvt_pk_bf16(s[6 * 65], s[7 * 65]);
        if (tiledNR) *(u32x4*)(WT + ((size_t)(k0 >> 6) * tiledNR + rbase + n) * 64 + 8 * c) = o; else *(u32x4*)(WT + (size_t)(rbase + n) * K + k0 + 8 * c) = o; }
    asm volatile("s_waitcnt lgkmcnt(0)" ::: "memory");
}
template <bool TILED>
__device__ __forceinline__ void rms_row_to_bf16(const float* xrow, const float* gain, bf16_t* obase, int m, int lane, float* rsout = nullptr) {
    f32x4 v[8]; float s = 0.f;
#pragma unroll
    for (int j = 0; j < 8; ++j) { v[j] = *(const f32x4*)(xrow + 4 * lane + 256 * j); s += (v[j][0] * v[j][0] + v[j][1] * v[j][1]) + (v[j][2] * v[j][2] + v[j][3] * v[j][3]); }
    const float rs = rsqrtf(wave_sum(s) * (1.0f / 2048.0f) + EPS);
    if (rsout && lane == 0) rsout[m] = rs;
#pragma unroll
    for (int j = 0; j < 8; ++j) { const f32x4 g = *(const f32x4*)(gain + 4 * lane + 256 * j); const f32x4 y = v[j] * g * rs; u32x2 w; w.x = cvt_pk_bf16(y[0], y[1]); w.y = cvt_pk_bf16(y[2], y[3]);
        const int c = 4 * lane + 256 * j;
        if (TILED) *(u32x2*)(obase + ((size_t)(c >> 6) * T + m) * 64 + (c & 63)) = w; else *(u32x2*)(obase + (size_t)m * D + c) = w; }
}

template <int W>
__device__ __forceinline__ void pool_elem(const bf16_t* PN, const float* pscale, bf16_t* MIX, int tA, int tB, bool hasB, int c) {
    const int tt[2] = {tA, hasB ? tB : tA};
    u32x4 cj[2][W]; int cnt[2];
#pragma unroll
    for (int q = 0; q < 2; ++q) { const int spos = tt[q] & (SEQ - 1); cnt[q] = (spos + 1 < W) ? spos + 1 : W; const char* up = (const char*)(PN + (size_t)tt[q] * 4096 + c);
#pragma unroll
        for (int j = 0; j < W; ++j) { const unsigned jj = (j < cnt[q]) ? (unsigned)j : 0u; cj[q][j] = *(const u32x4*)(up - jj * 8192u); } }
    const f32x4 p0 = *(const f32x4*)(pscale + c), p1 = *(const f32x4*)(pscale + c + 4);
#pragma unroll
    for (int q = 0; q < 2; ++q) { const float inv = 1.0f / (float)cnt[q];
        float s[8] = {0.f, 0.f, 0.f, 0.f, 0.f, 0.f, 0.f, 0.f};
#pragma unroll
        for (int j = 0; j < W; ++j) { const float m = (j < cnt[q]) ? 1.0f : 0.0f; const u32x4 v = cj[q][j];
            s[0] += m * bf_lo(v.x); s[1] += m * bf_hi(v.x); s[2] += m * bf_lo(v.y); s[3] += m * bf_hi(v.y);
            s[4] += m * bf_lo(v.z); s[5] += m * bf_hi(v.z); s[6] += m * bf_lo(v.w); s[7] += m * bf_hi(v.w); }
        const u32x4 z0 = cj[q][0];
        u32x4 w; w.x = cvt_pk_bf16((s[0] * inv - bf_lo(z0.x)) * p0[0], (s[1] * inv - bf_hi(z0.x)) * p0[1]); w.y = cvt_pk_bf16((s[2] * inv - bf_lo(z0.y)) * p0[2], (s[3] * inv - bf_hi(z0.y)) * p0[3]);
        w.z = cvt_pk_bf16((s[4] * inv - bf_lo(z0.z)) * p1[0], (s[5] * inv - bf_hi(z0.z)) * p1[1]); w.w = cvt_pk_bf16((s[6] * inv - bf_lo(z0.w)) * p1[2], (s[7] * inv - bf_hi(z0.w)) * p1[3]);
        if (q == 0 || hasB) *(u32x4*)(MIX + ((size_t)(c >> 6) * T + tt[q]) * 64 + (c & 63)) = w; }
}

#define XB_TMO      128
#define XB_XCNT(j)  (256  + 64 * (j))
#define XB_XSUB(j)  (1280 + 64 * (j))
#define XB_XGEN(j)  (2304 + 64 * (j))
#define XB_TOP      3328
#define XB_TOPGEN   3392
#define XCD_BAR_WORDS 3456
#define XB_SPIN_CAP (1u << 18)

__device__ __forceinline__ unsigned xb_ld(unsigned* p)              { return __hip_atomic_load(p, __ATOMIC_RELAXED, __HIP_MEMORY_SCOPE_AGENT); }
__device__ __forceinline__ unsigned xb_add(unsigned* p, unsigned v) { return __hip_atomic_fetch_add(p, v, __ATOMIC_RELAXED, __HIP_MEMORY_SCOPE_AGENT); }
__device__ __forceinline__ unsigned xb_xcc_id() { return (unsigned)__builtin_amdgcn_s_getreg((3 << 11) | 20) & 0xFu; }
#define XB_SPIN(cond, bar) do { unsigned _sp = 0; while (cond) { __builtin_amdgcn_s_sleep(1); \
    if ((++_sp & 255u) == 0u) { if (xb_ld(&(bar)[XB_TMO])) break; if (_sp > XB_SPIN_CAP) { atomicAdd(&(bar)[XB_TMO], 1u); break; } } } } while (0)

struct XcdBarrier {
    unsigned* bar; unsigned x;
    volatile LAS unsigned* st;
};

__device__ __forceinline__ XcdBarrier xcd_barrier_post(unsigned* bar, volatile LAS unsigned* st) {
    XcdBarrier b; b.bar = bar; b.x = xb_xcc_id(); b.st = st;
    if (threadIdx.x == 0) (void)xb_add(&bar[XB_XCNT(b.x)], 1u);
    return b;
}
__device__ __forceinline__ void xcd_barrier_complete(unsigned* bar, unsigned x, unsigned& nloc, unsigned& nx) {
    const unsigned G = gridDim.x * gridDim.y * gridDim.z;
    unsigned sum, cnt, mine, sp = 0u;
    for (;;) {
        sum = 0u; cnt = 0u; mine = 0u;
#pragma unroll
        for (unsigned j = 0; j < 16; ++j) { const unsigned c = xb_ld(&bar[XB_XCNT(j)]); sum += c; cnt += (c > 0u) ? 1u : 0u; mine = (j == x) ? c : mine; }
        if (sum == G) break;
        __builtin_amdgcn_s_sleep(1);
        if ((++sp & 255u) == 0u) { if (xb_ld(&bar[XB_TMO])) break; if (sp > XB_SPIN_CAP) { atomicAdd(&bar[XB_TMO], 1u); break; } }
    }
    nloc = mine > 0u ? mine : 1u; nx = cnt > 0u ? cnt : 1u;
}

__device__ __forceinline__ void xcd_barrier(const XcdBarrier& b) {
    asm volatile("s_waitcnt vmcnt(0)" ::: "memory");
    __syncthreads();
    if (threadIdx.x == 0) {
        unsigned* bar = b.bar;
        __builtin_amdgcn_s_waitcnt(0);
        unsigned nloc = b.st[0], nx = b.st[1];
        if (nloc == 0u) { xcd_barrier_complete(bar, b.x, nloc, nx); b.st[0] = nloc; b.st[1] = nx; }
        const unsigned old = xb_add(&bar[XB_XSUB(b.x)], 1u);
        const unsigned gen = old / nloc;
        if (old + 1u == (gen + 1u) * nloc) {
            __builtin_amdgcn_fence(__ATOMIC_RELEASE, "agent");
            asm volatile("s_waitcnt vmcnt(0)" ::: "memory");
            const unsigned og = xb_add(&bar[XB_TOP], 1u);
            const unsigned tg = og / nx;
            if (og + 1u == (tg + 1u) * nx) xb_add(&bar[XB_TOPGEN], 1u);
            else XB_SPIN(xb_ld(&bar[XB_TOPGEN]) == tg, bar);
            __builtin_amdgcn_fence(__ATOMIC_ACQUIRE, "agent");
            xb_add(&bar[XB_XGEN(b.x)], 1u);
            asm volatile("s_waitcnt vmcnt(0)" ::: "memory");
        } else {
            XB_SPIN(xb_ld(&bar[XB_XGEN(b.x)]) == gen, bar);
            __builtin_amdgcn_fence(__ATOMIC_ACQUIRE, "agent");
            asm volatile("s_waitcnt vmcnt(0)" ::: "memory");
        }
    }
    __syncthreads();
}

#define GRID_SYNC() xcd_barrier(xbar)
__global__ void __launch_bounds__(NTHR, 2) fwd_megakernel(Params p) {
    extern __shared__ __attribute__((aligned(16))) unsigned char lds_raw[];
    LAS unsigned char* lds = (LAS unsigned char*)lds_raw;
    cg::grid_group grid = cg::this_grid();
    const int tid = threadIdx.x, lane = tid & 63, wave = __builtin_amdgcn_readfirstlane(tid >> 6), fr = lane & 15, fq = lane >> 4;
    const int bx = blockIdx.x, G = gridDim.x;
    const int gw = bx * 8 + wave, NGW = G * 8;
    const size_t gtid = (size_t)bx * NTHR + tid, NGT = (size_t)G * NTHR;
    unsigned char* ws = p.ws;
    volatile LAS unsigned* xst = (volatile LAS unsigned*)(lds + 133120);
    if (tid < 2) xst[tid] = 0u;
    __syncthreads();
    XcdBarrier xbar = xcd_barrier_post((unsigned*)(ws + WS_BAR), xst);
    if (p.ws == nullptr) grid.sync();
    float* SS = (float*)(ws + WS_SS); float* ALR = (float*)(ws + WS_ALR); float* BEND = (float*)(ws + WS_BEND);
    bf16_t* MEMH = (bf16_t*)(ws + WS_MEMH); bf16_t* MEMK = (bf16_t*)(ws + WS_MEMK); bf16_t* MEMVT = (bf16_t*)(ws + WS_MEMVT);
    bf16_t* W1GU = (bf16_t*)(ws + WS_W1GU); bf16_t* W1D = (bf16_t*)(ws + WS_W1D); bf16_t* W2GU = (bf16_t*)(ws + WS_W2GU); bf16_t* W2D = (bf16_t*)(ws + WS_W2D);
    bf16_t* WIN = (bf16_t*)(ws + WS_WIN); bf16_t* WA = (bf16_t*)(ws + WS_WA); bf16_t* POOLW = (bf16_t*)(ws + WS_POOLW); bf16_t* WOUT = (bf16_t*)(ws + WS_WOUT);
    bf16_t* WQ = (bf16_t*)(ws + WS_WQ); bf16_t* WKV = (bf16_t*)(ws + WS_WKV); bf16_t* WO = (bf16_t*)(ws + WS_WO);
    bf16_t* H = (bf16_t*)(ws + WS_H); bf16_t* ACT = (bf16_t*)(ws + WS_ACT); bf16_t* MIX = (bf16_t*)(ws + WS_MIX);
    bf16_t* PN = ACT; bf16_t* KT = (bf16_t*)(ws + WS_ACT + ACT_KT); bf16_t* VT = (bf16_t*)(ws + WS_ACT + ACT_VT);
    bf16_t* PATT = (bf16_t*)(ws + WS_ACT + ACT_PATT); bf16_t* WQK = (bf16_t*)(ws + WS_ACT + ACT_WQK); bf16_t* VWOT = (bf16_t*)(ws + WS_ACT + ACT_VWOT);
    bf16_t* KV = (bf16_t*)p.out;
    float* RS0 = (float*)(ws + WS_RS0);
    LAS float* RSL = (LAS float*)(lds + 135168);

    {
        LAS float* scr = (LAS float*)(lds + wave * 16640);
        constexpr int I_FF = (D / 64) * (FF / 64);
        constexpr int I_IN = (D / 64) * (4096 / 64);
        constexpr int I_DD = (D / 64) * (D / 64);
        constexpr int I_INR = (D / 64) * (3072 / 64);
        constexpr int NITEMS = 6 * I_FF + I_INR + 64 + I_DD * 2 + I_IN;
        for (int it = gw; it < NITEMS; it += NGW) {
            int r = it;
            if (r < I_FF) { conv_item(p.ffn1_wg, D, FF, FF / 64, W1GU, 1, scr, r, lane, 2 * FF); continue; } r -= I_FF;
            if (r < I_FF) { conv_item(p.ffn1_wu, D, FF, FF / 64, W1GU, 2, scr, r, lane, 2 * FF); continue; } r -= I_FF;
            if (r < I_FF) { conv_item(p.ffn1_wd, FF, D, D / 64, W1D, 0, scr, r, lane, D); continue; } r -= I_FF;
            if (r < I_FF) { conv_item(p.ffn2_wg, D, FF, FF / 64, W2GU, 1, scr, r, lane, 2 * FF); continue; } r -= I_FF;
            if (r < I_FF) { conv_item(p.ffn2_wu, D, FF, FF / 64, W2GU, 2, scr, r, lane, 2 * FF); continue; } r -= I_FF;
            if (r < I_FF) { conv_item(p.ffn2_wd, FF, D, D / 64, W2D, 0, scr, r, lane, D); continue; } r -= I_FF;
            if (r < I_INR) { conv_item(p.w_in + 1024, D, 4112, 3072 / 64, WIN + (size_t)1024 * 64, 0, scr, r, lane, 4096); continue; } r -= I_INR;
            if (r < 64) { const int g = r >> 4; conv_item(p.pool_w + (size_t)g * 65536, 256, 256, 4, POOLW + (size_t)g * 65536, 0, scr, r & 15, lane); continue; } r -= 64;
            if (r < I_DD) { conv_item(p.w_out, D, D, D / 64, WOUT, 0, scr, r, lane, D); continue; } r -= I_DD;
            if (r < I_DD) { conv_item(p.wo, D, D, D / 64, WO, 0, scr, r, lane); continue; } r -= I_DD;
            conv_item(p.wkv, D, 4096, 4096 / 64, WKV, 0, scr, r, lane);
        }
        for (size_t i = gtid; i < (size_t)D * D / 8; i += NGT) { const f32x4 a = ((const f32x4*)p.wq)[2 * i], b = ((const f32x4*)p.wq)[2 * i + 1];
            u32x4 w; w.x = cvt_pk_bf16(a[0], a[1]); w.y = cvt_pk_bf16(a[2], a[3]); w.z = cvt_pk_bf16(b[0], b[1]); w.w = cvt_pk_bf16(b[2], b[3]); ((u32x4*)WQ)[i] = w; }
        for (size_t i = gtid; i < (size_t)D * 1024 / 8; i += NGT) { const size_t kd = i >> 7, c = (i & 127) * 8; const float* src = p.w_in + kd * 4112 + c;
            const f32x4 a = *(const f32x4*)src, b = *(const f32x4*)(src + 4);
            u32x4 w; w.x = cvt_pk_bf16(a[0], a[1]); w.y = cvt_pk_bf16(a[2], a[3]); w.z = cvt_pk_bf16(b[0], b[1]); w.w = cvt_pk_bf16(b[2], b[3]); ((u32x4*)MIX)[i] = w; }
        for (size_t i = gtid; i < 32768; i += NGT) { const int k = (int)(i >> 4), r = (int)(i & 15); WA[r * D + k] = (bf16_t)cvt_pk_bf16(p.w_in[(size_t)k * 4112 + 4096 + r], 0.f); }
        for (int m = gw; m < T + MEMT; m += NGW) {
            if (m < T) rms_row_to_bf16<true>(p.x + (size_t)m * D, p.ffn1_norm, H, m, lane, RS0);
            else rms_row_to_bf16<false>(p.mem + (size_t)(m - T) * D, p.mem_norm, MEMH, m - T, lane);
        }
    }
    GRID_SYNC();
    { pg8::StdOrder S; S.init(T, 2 * FF, G, bx, H, 64, W1GU, 64); pg8::EpiSwiglu E{ACT, false, RowScale{nullptr, nullptr, -1}}; pg8::gemm_phase<true>(lds, 64, 64, D, S, E, (size_t)T * 64 * 2, (size_t)2 * FF * 64 * 2); }
    GRID_SYNC();
    { pg8::StdOrder S; S.init(T, D, G, bx, ACT, 64, W1D, 64); S.wgm = 4; pg8::EpiResid E{H, p.ffn1_norm, RS0, p.mix_norm, SS, 0.5f}; pg8::gemm_phase<true>(lds, 64, 64, FF, S, E, (size_t)T * 64 * 2, (size_t)D * 64 * 2); }
    { pg8::WinFoldOrder S{bx, (const char*)POOLW, (const char*)MIX}; pg8::EpiTile E{WIN, (size_t)4096}; pg8::gemm_phase<true>(lds, 256, 1024, 256, S, E); }
    GRID_SYNC();
    {
        { pg8::StdOrder S; S.init(T, 4096, G, bx, H, 64, WIN, 64); pg8::Unit u0; u0.pm = -1; (void)S.next(0, u0); if (u0.pm >= 0) fill_rsl(RSL, SS, u0.pm);
          pg8::EpiWin E{PN, KT, VT, RowScale{SS, RSL, u0.pm}}; pg8::gemm_phase<true>(lds, 64, 64, D, S, E, (size_t)T * 64 * 2, (size_t)4096 * 64 * 2); }
        {
            const int tb = wave & 3, kh = wave >> 2; const int tok = bx * 64 + tb * 16 + fr;
            const bf16_t* ap = H + ((size_t)(kh * 16) * T + tok) * 64 + fq * 8; const bf16_t* wp = WA + (size_t)fr * D + kh * 1024 + fq * 8;
            f32x4 acc = {0.f, 0.f, 0.f, 0.f};
#pragma unroll 8
            for (int ks = 0; ks < 32; ++ks) { const bf16x8 wf = *(const bf16x8*)(wp + ks * 32), af = *(const bf16x8*)(ap + (size_t)(ks >> 1) * T * 64 + (ks & 1) * 32); acc = __builtin_amdgcn_mfma_f32_16x16x32_bf16(wf, af, acc, 0, 0, 0); }
            LAS f32x4* ex = (LAS f32x4*)lds;
            if (kh == 1) ex[tb * 64 + lane] = acc;
            __syncthreads();
            if (kh == 0) { const f32x4 o = (acc + ex[tb * 64 + lane]) * rstd_of(SS, tok); *(f32x4*)(ALR + (size_t)tok * 16 + 4 * fq) = o; }
        }
    }
    GRID_SYNC();
    constexpr int GA = 224;
    if (bx >= GA) { pg8::MemKVOrder S{bx - GA, (const char*)MEMH, (const char*)WKV}; pg8::EpiMemKV E{MEMK, MEMVT}; pg8::gemm_phase<true>(lds, D, D, D, S, E); }
    else {
        LAS float* alr_s = (LAS float*)lds; LAS float* w2_s = (LAS float*)(lds + 4096); LAS float* ba_s = (LAS float*)(lds + 12288); LAS float* gsum = (LAS float*)(lds + 12800);
        LAS bf16_t* KD = (LAS bf16_t*)(lds + 16384);
        {
            const int h = bx & 3; const int k = tid & 127, fg = tid >> 7;
            { const int idx = tid * 4, r = idx >> 7, kk = idx & 127; *(LAS f32x4*)(w2_s + idx) = *(const f32x4*)(p.gla_w_a2 + r * 512 + h * 128 + kk); }
            const float bk = p.gla_b_a[h * 128 + k];
            __syncthreads();
            float w[16];
#pragma unroll
            for (int r = 0; r < 16; ++r) w[r] = w2_s[r * 128 + k];
            f32x4 n_alr = {0.f, 0.f, 0.f, 0.f}; u32x4 n_k0, n_k1; bf16x8 n_vf[2][2];
#define GLA_A_PREFETCH(uu) do { if (tid < 256) n_alr = ((const f32x4*)(ALR + (size_t)((uu) >> 2) * 64 * 16))[tid]; \
                { const u32x4* kp_ = (const u32x4*)(KT + (size_t)(uu) * 8192 + (size_t)k * 64 + fg * 16); n_k0 = kp_[0]; n_k1 = kp_[1]; } \
                _Pragma("unroll") for (int vv = 0; vv < 2; ++vv) _Pragma("unroll") for (int ks = 0; ks < 2; ++ks) \
                    n_vf[vv][ks] = *(const bf16x8*)(VT + (size_t)(uu) * 16384 + (size_t)((2 * wave + vv) * 16 + fr) * 64 + ks * 32 + fq * 8); } while (0)
            GLA_A_PREFETCH(bx);
            for (int u = bx; u < 1024; u += GA) {
                const f32x4 c_alr = n_alr; const u32x4 k0 = n_k0, k1 = n_k1; bf16x8 vf[2][2];
#pragma unroll
                for (int vv = 0; vv < 2; ++vv)
#pragma unroll
                    for (int ks = 0; ks < 2; ++ks) vf[vv][ks] = n_vf[vv][ks];
                if (u + GA < 1024) GLA_A_PREFETCH(u + GA);
                if (tid < 256) ((LAS f32x4*)alr_s)[tid] = c_alr;
                __syncthreads();
                float cum[16]; float run = 0.f;
#pragma unroll
                for (int ii = 0; ii < 16; ++ii) { const int i = fg * 16 + ii; float z = bk;
#pragma unroll
                    for (int r = 0; r < 16; ++r) z += alr_s[i * 16 + r] * w[r];
                    const float la = -(fmaxf(-z, 0.f) + __logf(1.0f + __expf(-fabsf(z)))) * (1.0f / 16.0f);
                    run += la; cum[ii] = run; }
                gsum[fg * 128 + k] = run;
                __syncthreads();
                float prefix = 0.f, total = 0.f;
#pragma unroll
                for (int f = 0; f < 4; ++f) { const float gsv = gsum[f * 128 + k]; total += gsv; if (f < fg) prefix += gsv; }
                if (fg == 0) BEND[(size_t)u * 128 + k] = total;
                { const unsigned kw[8] = {k0.x, k0.y, k0.z, k0.w, k1.x, k1.y, k1.z, k1.w}; unsigned ow[8];
#pragma unroll
                  for (int q = 0; q < 8; ++q) { const float d0 = __expf(total - (cum[2 * q] + prefix)), d1 = __expf(total - (cum[2 * q + 1] + prefix)); ow[q] = cvt_pk_bf16(bf_lo(kw[q]) * d0, bf_hi(kw[q]) * d1); }
                  LAS u32x4* dst = (LAS u32x4*)(KD + k * 72 + fg * 16); dst[0] = (u32x4){ow[0], ow[1], ow[2], ow[3]}; dst[1] = (u32x4){ow[4], ow[5], ow[6], ow[7]}; }
                __syncthreads();
#pragma unroll
                for (int kp = 0; kp < 4; ++kp) { u32x2 w0[2], w1[2];
#pragma unroll
                    for (int kq = 0; kq < 2; ++kq) { const int kb = 2 * kp + kq; f32x4 a0 = {0.f, 0.f, 0.f, 0.f}, a1 = {0.f, 0.f, 0.f, 0.f};
#pragma unroll
                        for (int ks = 0; ks < 2; ++ks) { const bf16x8 kf = *(const LAS bf16x8*)(KD + (kb * 16 + fr) * 72 + ks * 32 + fq * 8);
                            a0 = __builtin_amdgcn_mfma_f32_16x16x32_bf16(kf, vf[0][ks], a0, 0, 0, 0); a1 = __builtin_amdgcn_mfma_f32_16x16x32_bf16(kf, vf[1][ks], a1, 0, 0, 0); }
                        w0[kq].x = cvt_pk_bf16(a0[0], a0[1]); w0[kq].y = cvt_pk_bf16(a0[2], a0[3]); w1[kq].x = cvt_pk_bf16(a1[0], a1[1]); w1[kq].y = cvt_pk_bf16(a1[2], a1[3]); }
                    const int eo = kp * 32 + (fq & 1) * 16 + (fq >> 1) * 8;
                    *(u32x4*)(KV + (size_t)u * 32768 + (size_t)((2 * wave) * 16 + fr) * 128 + eo) = pair16(w0[0], w0[1]);
                    *(u32x4*)(KV + (size_t)u * 32768 + (size_t)((2 * wave + 1) * 16 + fr) * 128 + eo) = pair16(w1[0], w1[1]); }
                __syncthreads();
            }
#undef GLA_A_PREFETCH
        }
        { const int gwp = bx * 8 + wave; constexpr int NWP = GA * 8;
          for (int g = 0; g < 4; ++g)
            for (int tp = gwp; tp < 8192; tp += 2 * NWP) { const int tpB = tp + NWP; const bool hasB = tpB < 8192;
                const int tA = 2 * tp + (lane >> 5), tB = 2 * tpB + (lane >> 5), c = g * 256 + (lane & 31) * 8;
                if (g == 0) pool_elem<2>(PN, p.pool_scale, MIX, tA, tB, hasB, c);
                else if (g == 1) pool_elem<4>(PN, p.pool_scale, MIX, tA, tB, hasB, c);
                else if (g == 2) pool_elem<8>(PN, p.pool_scale, MIX, tA, tB, hasB, c);
                else pool_elem<16>(PN, p.pool_scale, MIX, tA, tB, hasB, c); } }
    }
    GRID_SYNC();
    {
        int t5 = threadIdx.x; asm volatile("" : "+v"(t5));
        if (bx < 128) {
            const int e = bx * NTHR + t5; const int bh = e >> 13, qd = e & 8191; const int b = bh >> 2, h = bh & 3; const int k = 4 * (qd & 31);
            f32x4 st = {0.f, 0.f, 0.f, 0.f};
            for (int c0 = 0; c0 < 128; c0 += 16) {
                u32x2 kvw[16]; f32x4 gm[16];
#pragma unroll
                for (int q = 0; q < 16; ++q) { const size_t u = (size_t)((b * 128 + c0 + q) * 4 + h); kvw[q] = *(const u32x2*)(KV + u * 32768 + 4 * qd); gm[q] = *(const f32x4*)(BEND + u * 128 + k); }
#pragma unroll
                for (int q = 0; q < 16; ++q) { const size_t u = (size_t)((b * 128 + c0 + q) * 4 + h);
                    st[0] = __expf(gm[q][0]) * st[0] + bf_lo(kvw[q].x); st[1] = __expf(gm[q][1]) * st[1] + bf_hi(kvw[q].x);
                    st[2] = __expf(gm[q][2]) * st[2] + bf_lo(kvw[q].y); st[3] = __expf(gm[q][3]) * st[3] + bf_hi(kvw[q].y);
                    u32x2 o; o.x = cvt_pk_bf16(st[0], st[1]); o.y = cvt_pk_bf16(st[2], st[3]);
                    *(u32x2*)(KV + u * 32768 + 4 * qd) = o; }
            }
        }
        { pg8::WqKOrder S{bx - 128, (const char*)MEMK, (const char*)WQ}; pg8::EpiTile E{WQK, (size_t)1024}; pg8::gemm_phase<true>(lds, 512, D, 512, S, E); }
        { pg8::VWoOrder S{bx - 192, (const char*)WO, (const char*)MEMVT}; pg8::EpiTile E{VWOT, (size_t)D}; pg8::gemm_phase<true>(lds, D, 512, 512, S, E); }
    }
    GRID_SYNC();
    {
        LAS float* exch = (LAS float*)lds;
        f32x4 hn[8];
#pragma unroll
        for (int vb = 0; vb < 8; ++vb) hn[vb] = *(const f32x4*)(p.gla_head_norm + (bx & 3) * 256 + (wave >> 2) * 128 + vb * 16 + 4 * fq);
        for (int u = bx; u < 1024; u += G) {
            const int h = u & 3, chunk = u >> 2; const int t0 = chunk * 64; const int tb = wave & 3, vh = wave >> 2; const int t = t0 + tb * 16 + fr;
            u32x2 gt[8];
#pragma unroll
            for (int vb = 0; vb < 8; ++vb) gt[vb] = *(const u32x2*)(PN + (size_t)t * 4096 + 3072 + h * 256 + vh * 128 + vb * 16 + 4 * fq);
            bf16x8 qf[4];
#pragma unroll
            for (int ks = 0; ks < 4; ++ks) qf[ks] = *(const bf16x8*)(PN + (size_t)t * 4096 + 1024 + h * 128 + ks * 32 + fq * 8);
            f32x4 acc[8]; float ssq = 0.f;
#pragma unroll
            for (int vb = 0; vb < 8; ++vb) { f32x4 a = {0.f, 0.f, 0.f, 0.f};
#pragma unroll
                for (int ks = 0; ks < 4; ++ks) { const bf16x8 sf = *(const bf16x8*)(KV + (size_t)u * 32768 + (size_t)((vh * 8 + vb) * 16 + fr) * 128 + ks * 32 + fq * 8); a = __builtin_amdgcn_mfma_f32_16x16x32_bf16(sf, qf[ks], a, 0, 0, 0); }
                a = a * 0.08838834764f; acc[vb] = a; ssq += (a[0] * a[0] + a[1] * a[1]) + (a[2] * a[2] + a[3] * a[3]); }
            ssq += __shfl_xor(ssq, 16); ssq += __shfl_xor(ssq, 32);
            if (fq == 0) exch[(vh * 4 + tb) * 16 + fr] = ssq;
            __syncthreads();
            const float tot = exch[tb * 16 + fr] + exch[(4 + tb) * 16 + fr]; const float rs = rsqrtf(tot * (1.0f / 256.0f) + EPS);
#pragma unroll
            for (int vp = 0; vp < 4; ++vp) { u32x2 w2[2];
#pragma unroll
                for (int vq = 0; vq < 2; ++vq) { const int vb = 2 * vp + vq; const u32x2 gw2 = gt[vb];
                    const f32x4 o = acc[vb] * rs * hn[vb]; w2[vq].x = cvt_pk_bf16(o[0] * silu_f(bf_lo(gw2.x)), o[1] * silu_f(bf_hi(gw2.x))); w2[vq].y = cvt_pk_bf16(o[2] * silu_f(bf_lo(gw2.y)), o[3] * silu_f(bf_hi(gw2.y))); }
                const int cm = 1024 + h * 256 + vh * 128 + vp * 32 + (fq & 1) * 16 + (fq >> 1) * 8;
                *(u32x4*)(MIX + ((size_t)(cm >> 6) * T + t) * 64 + (cm & 63)) = pair16(w2[0], w2[1]); }
            __syncthreads();
        }
    }
    GRID_SYNC();
    { pg8::StdOrder S; S.init(T, D, G, bx, MIX, 64, WOUT, 64); pg8::EpiResid E{H, p.mix_norm, nullptr, p.xattn_norm, SS + 32 * T, 1.0f}; pg8::gemm_phase<true>(lds, 64, 64, D, S, E, (size_t)T * 64 * 2, (size_t)D * 64 * 2); }
    GRID_SYNC();
    { pg8::LogitOrder S{bx, (const char*)H, (const char*)WQK}; pg8::Unit u0; u0.pm = -1; (void)S.next(0, u0); if (u0.pm >= 0) fill_rsl(RSL, SS + 32 * T, u0.pm);
      pg8::EpiSoftmax E{PATT, RowScale{SS + 32 * T, RSL, u0.pm}}; pg8::gemm_phase<false>(lds, 64, 64, D, S, E, (size_t)T * 64 * 2, (size_t)1024 * 64 * 2); }
    GRID_SYNC();
    { pg8::StdOrder S; S.init(T, D, G, bx, PATT, 64, VWOT, 64); S.bbatch = (size_t)D * 1024 * 2; pg8::EpiResid E{H, p.xattn_norm, nullptr, p.ffn2_norm, SS + 64 * T, 1.0f}; pg8::gemm_phase<true>(lds, 64, 64, 1024, S, E, (size_t)T * 64 * 2, (size_t)D * 64 * 2); }
    GRID_SYNC();
    { pg8::StdOrder S; S.init(T, 2 * FF, G, bx, H, 64, W2GU, 64); pg8::Unit u0; u0.pm = -1; (void)S.next(0, u0); if (u0.pm >= 0) fill_rsl(RSL, SS + 64 * T, u0.pm);
      pg8::EpiSwiglu E{ACT, true, RowScale{SS + 64 * T, RSL, u0.pm}}; pg8::gemm_phase<true>(lds, 64, 64, D, S, E, (size_t)T * 64 * 2, (size_t)2 * FF * 64 * 2); }
    GRID_SYNC();
    { pg8::StdOrder S; S.init(T, D, G, bx, ACT, 64, W2D, 64); S.wgm = 4; pg8::EpiResid E{H, p.ffn2_norm, nullptr, p.final_norm, SS + 96 * T, 0.5f};   pg8::gemm_phase<true>(lds, 64, 64, FF, S, E, (size_t)T * 64 * 2, (size_t)D * 64 * 2); }
    GRID_SYNC();
    { int t14 = threadIdx.x; asm volatile("" : "+v"(t14)); const int l14 = t14 & 63, gw14 = blockIdx.x * 8 + (t14 >> 6);
      const float* ss3 = SS + 96 * T;
      for (int m = gw14; m < T; m += NGW) {
          const float part = (l14 < 32) ? ss3[(size_t)m * 32 + l14] : 0.f; const float rs = rsqrtf(wave_sum(part) * (1.0f / 2048.0f) + EPS);
#pragma unroll
          for (int j4 = 0; j4 < 4; ++j4) { const int col = (l14 + 64 * j4) * 8; const u32x4 w = *(const u32x4*)(H + ((size_t)(col >> 6) * T + m) * 64 + (col & 63));
              f32x4 a, b; a[0] = bf_lo(w.x) * rs; a[1] = bf_hi(w.x) * rs; a[2] = bf_lo(w.y) * rs; a[3] = bf_hi(w.y) * rs; b[0] = bf_lo(w.z) * rs; b[1] = bf_hi(w.z) * rs; b[2] = bf_lo(w.w) * rs; b[3] = bf_hi(w.w) * rs;
              *(f32x4*)(p.out + (size_t)m * D + col) = a; *(f32x4*)(p.out + (size_t)m * D + col + 4) = b; } } }
}

extern "C" void kernel_launch(void* const* d_in, const int* in_sizes, int n_in, void* d_out, int out_size, void* d_ws, size_t ws_size, hipStream_t stream) {
    static int grid = 0;
    if (grid == 0) {
        if (n_in != 24 || out_size != T * D || ws_size < WS_END) { fprintf(stderr, "kernel_launch: unexpected shapes n_in %d out %d ws %zu (need %zu)\n", n_in, out_size, ws_size, (size_t)WS_END); grid = -1; return; }
        int dev = 0, cus = 0, per_cu = 0;
        (void)hipGetDevice(&dev); (void)hipDeviceGetAttribute(&cus, hipDeviceAttributeMultiprocessorCount, dev);
        (void)hipFuncSetAttribute((const void*)fwd_megakernel, hipFuncAttributeMaxDynamicSharedMemorySize, LDS_BYTES);
        (void)hipOccupancyMaxActiveBlocksPerMultiprocessor(&per_cu, (const void*)fwd_megakernel, NTHR, LDS_BYTES);
        (void)hipGetLastError();
        grid = cus < NWG ? cus : NWG;
        if (per_cu < 1) fprintf(stderr, "kernel_launch: occupancy query says %d blocks/CU\n", per_cu);
    }
    if (grid < 0) return;
    if (hipMemsetAsync((char*)d_ws + WS_BAR, 0, 16384, stream) != hipSuccess) { fprintf(stderr, "kernel_launch: memset failed\n"); return; }
    Params p{};
    const float** pp = (const float**)&p;
    for (int i = 0; i < 24; ++i) pp[i] = (const float*)d_in[i];
    p.out = (float*)d_out; p.ws = (unsigned char*)d_ws;
    void* args[] = {&p};
    hipError_t e = hipLaunchCooperativeKernel((const void*)fwd_megakernel, dim3(grid), dim3(NTHR), args, LDS_BYTES, stream);
    if (e != hipSuccess) fprintf(stderr, "cooperative launch failed: %s (grid %d)\n", hipGetErrorString(e), grid);
}
```

```cpp
#include <hip/hip_runtime.h>
#include <hip/hip_cooperative_groups.h>
#include <cstdio>
#include <cstdint>
namespace cg = cooperative_groups;

#define LAS __attribute__((address_space(3)))
typedef unsigned short bf16_t;
typedef short bf16x8 __attribute__((ext_vector_type(8)));
typedef float f32x4 __attribute__((ext_vector_type(4)));
typedef float f32x2 __attribute__((ext_vector_type(2)));
typedef unsigned u32x4 __attribute__((ext_vector_type(4)));
typedef unsigned u32x2 __attribute__((ext_vector_type(2)));

constexpr int T = 16384, D = 2048, FF = 5632, SEQ = 8192, MEMT = 512;
constexpr int NWG = 256, NTHR = 512;
constexpr float EPS = 1e-6f;

constexpr size_t WS_BAR   = 0;
constexpr size_t WS_SS    = 16384;
constexpr size_t WS_ALR   = WS_SS + 4ull * T * 32 * 4;
constexpr size_t WS_BEND  = WS_ALR + (size_t)T * 16 * 4;
constexpr size_t WS_MEMH  = WS_BEND + 1024ull * 128 * 4;
constexpr size_t WS_MEMK  = WS_MEMH + (size_t)MEMT * D * 2;
constexpr size_t WS_MEMVT = WS_MEMK + (size_t)MEMT * D * 2;
constexpr size_t WS_W1GU  = WS_MEMVT + (size_t)MEMT * D * 2;
constexpr size_t WS_W1D   = WS_W1GU + 2ull * FF * D * 2;
constexpr size_t WS_W2GU  = WS_W1D + (size_t)FF * D * 2;
constexpr size_t WS_W2D   = WS_W2GU + 2ull * FF * D * 2;
constexpr size_t WS_WIN   = WS_W2D + (size_t)FF * D * 2;
constexpr size_t WS_WA    = WS_WIN + 4096ull * D * 2;
constexpr size_t WS_POOLW = WS_WA + 16ull * D * 2;
constexpr size_t WS_WOUT  = WS_POOLW + 4ull * 256 * 256 * 2;
constexpr size_t WS_WQ    = WS_WOUT + (size_t)D * D * 2;
constexpr size_t WS_WKV   = WS_WQ + (size_t)D * D * 2;
constexpr size_t WS_WO    = WS_WKV + 2ull * D * D * 2;
constexpr size_t WS_H     = WS_WO + (size_t)D * D * 2;
constexpr size_t WS_ACT   = WS_H + (size_t)T * D * 2;
constexpr size_t WS_MIX   = WS_ACT + (size_t)T * FF * 2;
constexpr size_t WS_RS0   = WS_MIX + (size_t)T * D * 2;
constexpr size_t WS_END   = WS_RS0 + (size_t)T * 4;
constexpr size_t ACT_KT   = (size_t)T * 4096 * 2;
constexpr size_t ACT_VT   = ACT_KT + 1024ull * 8192 * 2;
constexpr size_t ACT_PATT = (size_t)T * D * 2;
constexpr size_t ACT_WQK  = ACT_KT;
constexpr size_t ACT_VWOT = ACT_WQK + 2ull * 1024 * D * 2;

constexpr int LDS_BYTES = 139264;

typedef __bf16 bf16x2_t __attribute__((ext_vector_type(2)));
__device__ __forceinline__ unsigned cvt_pk_bf16(float lo, float hi) { const f32x2 v = {lo, hi}; const bf16x2_t r = __builtin_convertvector(v, bf16x2_t); return __builtin_bit_cast(unsigned, r); }
__device__ __forceinline__ u32x4 pair16(u32x2 a, u32x2 b) {
    const auto rx = __builtin_amdgcn_permlane16_swap(a.x, b.x, false, false); const auto ry = __builtin_amdgcn_permlane16_swap(a.y, b.y, false, false);
    return (u32x4){rx[0], ry[0], rx[1], ry[1]};
}
template <int CTRL> __device__ __forceinline__ unsigned dpp_quad(unsigned x) { return (unsigned)__builtin_amdgcn_mov_dpp((int)x, CTRL, 0xf, 0xf, true); }
__device__ __forceinline__ float bf_lo(unsigned w) { return __uint_as_float(w << 16); }
__device__ __forceinline__ float bf_hi(unsigned w) { return __uint_as_float(w & 0xffff0000u); }
__device__ __forceinline__ float silu_f(float g) { return g * __builtin_amdgcn_rcpf(1.0f + __builtin_amdgcn_exp2f(-1.44269504f * g)); }
__device__ __forceinline__ float rstd_of(const float* ss, int row) {
    const f32x4* q = (const f32x4*)(ss + (size_t)row * 32); float s = 0.f;
#pragma unroll
    for (int j = 0; j < 8; ++j) { const f32x4 v = q[j]; s += (v[0] + v[1]) + (v[2] + v[3]); }
    return rsqrtf(s * (1.0f / 2048.0f) + EPS); }

struct RowScale { const float* ss; const LAS float* rsl; int pm0; };
__device__ __forceinline__ float row_rs(const RowScale& R, int pm, int lr) { return (R.rsl && pm == R.pm0) ? R.rsl[lr] : rstd_of(R.ss, pm * 256 + lr); }
__device__ __forceinline__ void fill_rsl(LAS float* rsl, const float* ss, int pm) { if (threadIdx.x < 256) rsl[threadIdx.x] = rstd_of(ss, pm * 256 + (int)threadIdx.x); __syncthreads(); }

namespace pg8 {
constexpr int BM = 256, BK = 64, HALF = 128, HTB = HALF * BK * 2, STAGE_BYTES = 8 * HTB, NXCD = 8, WGM = 8;
__device__ __forceinline__ int lds_byte(int r, int c) { const int st = (r >> 4) * 2 + (c >> 5), rr = r & 15, cc = c & 31, ob = rr * 64 + cc * 2; return st * 1024 + (ob ^ (((ob >> 9) & 1) << 5)); }
__device__ __forceinline__ void stage_rc(int b, int& R, int& C) { const int st = b / 1024, sb = b % 1024, swz = sb ^ (((sb >> 9) & 1) << 5); R = (st >> 1) * 16 + swz / 64; C = (st & 1) * 32 + (swz % 64) / 2; }
__device__ __forceinline__ int perm32(int rho) { const int n = rho >> 4, i = rho & 15; return 8 * (i >> 2) + 4 * n + (i & 3); }

struct Unit { int pm, pn, z; const char* a; const char* b; size_t o; int r0, c0; };

struct StdOrder {
    int nM, nN, nwg, G, c, wgm; const char* A; const char* B; size_t ta, tb, bbatch;
    __device__ void init(int M, int N, int G_, int c_, const void* A_, size_t lda, const void* B_, size_t ldb) { nM = M / BM; nN = N / BM; nwg = nM * nN; G = G_; c = c_; A = (const char*)A_; B = (const char*)B_; ta = (size_t)BM * lda * 2; tb = (size_t)BM * ldb * 2; bbatch = 0; wgm = WGM; }
    __device__ bool next(int i, Unit& u) const {
        const long L = (long)i * G + c; if (c >= G || L >= nwg) return false;
        int wgid = (int)L; { const int q = nwg / NXCD, r = nwg % NXCD, xcd = wgid % NXCD, off = wgid / NXCD; wgid = (xcd < r ? xcd * (q + 1) : r * (q + 1) + (xcd - r) * q) + off; }
        const int nig = wgm * nN, gid = wgid / nig, fm = gid * wgm, gsz = (nM - fm) < wgm ? (nM - fm) : wgm;
        u.pm = fm + ((wgid % nig) % gsz); u.pn = (wgid % nig) / gsz; u.z = 0; u.o = 0; u.r0 = 0; u.c0 = 0; u.a = A + (size_t)u.pm * ta; u.b = B + (size_t)u.pn * tb + ((u.pm >= (nM >> 1)) ? bbatch : (size_t)0); return true;
    }
};

template <bool ALIGN_EPI, class Epi, class Sched>
__device__ __forceinline__ void gemm_phase(LAS unsigned char* lds, const int lda, const int ldb, const int K, const Sched& S, const Epi& E, const size_t kstepA = (size_t)(BK * 2), const size_t kstepB = (size_t)(BK * 2)) {
    int tid = threadIdx.x; asm volatile("" : "+v"(tid));
    const int wid = __builtin_amdgcn_readfirstlane(tid >> 6), lane = tid & 63, wr = wid >> 2, wc = wid & 3, fr = lane & 15, fq = lane >> 4;
    const int nt = K / BK;
    unsigned voffA[2], voffB[2];
#pragma unroll
    for (int i = 0; i < 2; ++i) { int R, C; stage_rc(tid * 16 + i * 8192, R, C); const int Rb = (R & ~31) + perm32(R & 31);
        voffA[i] = (unsigned)(R * lda + C) * 2u; voffB[i] = (unsigned)(Rb * ldb + C) * 2u; }
    const size_t kstep = kstepB;
    const size_t hstepA = (size_t)HALF * lda * 2, hstepB = (size_t)HALF * ldb * 2;
    const unsigned ldsw = (unsigned)wid * 1024u;
    const int aoff = lds_byte(wr * 64 + fr, fq * 8), boff = lds_byte(wc * 32 + fr, fq * 8);
#define PG8_SA(b, h) (((b) * 2 + (h)) * HTB)
#define PG8_SB(b, h) ((4 + (b) * 2 + (h)) * HTB)
#define PG8_STAGE(bufoff, gbase, voff) do { _Pragma("unroll") for (int _i = 0; _i < 2; ++_i) \
        __builtin_amdgcn_global_load_lds((const unsigned*)((const char*)(gbase) + (voff)[_i]), (LAS unsigned*)(lds + (bufoff) + ldsw + _i * 8192), 16, 0, 0); } while (0)
#define PG8_LDA(dst, b, h) do { _Pragma("unroll") for (int m = 0; m < 4; ++m) _Pragma("unroll") for (int k = 0; k < 2; ++k) dst[m][k] = *(const LAS bf16x8*)(lds + PG8_SA(b, h) + aoff + m * 2048 + k * 1024); } while (0)
#define PG8_LDB(dst, b, h) do { _Pragma("unroll") for (int n = 0; n < 2; ++n) _Pragma("unroll") for (int k = 0; k < 2; ++k) dst[n][k] = *(const LAS bf16x8*)(lds + PG8_SB(b, h) + boff + n * 2048 + k * 1024); } while (0)
#define PG8_MMA(ai, bj, At, Bt) do { __builtin_amdgcn_s_setprio(1); _Pragma("unroll") for (int m = 0; m < 4; ++m) _Pragma("unroll") for (int n = 0; n < 2; ++n) _Pragma("unroll") for (int k = 0; k < 2; ++k) \
        acc[ai][bj][m][n] = __builtin_amdgcn_mfma_f32_16x16x32_bf16(Bt[n][k], At[m][k], acc[ai][bj][m][n], 0, 0, 0); __builtin_amdgcn_s_setprio(0); } while (0)
#define PG8_WAIT_V(n) asm volatile("s_waitcnt vmcnt(" #n ")" ::: "memory")
#define PG8_WAIT_L(n) asm volatile("s_waitcnt lgkmcnt(" #n ")" ::: "memory")
#define PG8_BAR __builtin_amdgcn_s_barrier()
#define PG8_SCHED __builtin_amdgcn_sched_barrier(0)
    Unit cur, nxt; int ui = 0;
    if (!S.next(0, cur)) return;
    f32x4 acc[2][2][4][2];
#pragma unroll
    for (int a = 0; a < 2; ++a)
#pragma unroll
        for (int b = 0; b < 2; ++b)
#pragma unroll
            for (int m = 0; m < 4; ++m)
#pragma unroll
                for (int n = 0; n < 2; ++n) acc[a][b][m][n] = (f32x4){0.f, 0.f, 0.f, 0.f};
    bf16x8 At[4][2], B0[2][2], B1[2][2];
    const char* cA = cur.a; const char* cB = cur.b;
    PG8_STAGE(PG8_SB(0, 0), cB, voffB); PG8_STAGE(PG8_SB(0, 1), cB + hstepB, voffB); PG8_STAGE(PG8_SA(0, 0), cA, voffA); PG8_STAGE(PG8_SA(0, 1), cA + hstepA, voffA);
    if (wr == 1) PG8_BAR;
    PG8_WAIT_V(2); PG8_BAR;
    PG8_STAGE(PG8_SB(1, 0), cB + kstep, voffB); PG8_STAGE(PG8_SA(1, 0), cA + kstepA, voffA); PG8_STAGE(PG8_SB(1, 1), cB + hstepB + kstep, voffB);
    PG8_WAIT_V(6); PG8_BAR;
    for (;;) {
        const bool has_next = S.next(ui + 1, nxt);
        const char* nA = has_next ? nxt.a : cA; const char* nB = has_next ? nxt.b : cB;
#pragma unroll 1
        for (int t = 0; t < nt; t += 2) {
            const bool last = (t == nt - 2);
            const char* a1 = cA + (size_t)(t + 1) * kstepA;
            const char* a2 = last ? nA : cA + (size_t)(t + 2) * kstepA; const char* b2 = last ? nB : cB + (size_t)(t + 2) * kstep;
            const char* a3 = a2 + kstepA; const char* b3 = b2 + kstep;
            PG8_LDB(B0, 0, 0); PG8_LDB(B1, 0, 1); PG8_SCHED; PG8_LDA(At, 0, 0); PG8_STAGE(PG8_SA(1, 1), a1 + hstepA, voffA);
            PG8_WAIT_V(8); PG8_WAIT_L(0); PG8_BAR; PG8_MMA(0, 0, At, B0); PG8_MMA(0, 1, At, B1); PG8_BAR; PG8_SCHED;
            PG8_LDA(At, 0, 1); PG8_STAGE(PG8_SB(0, 0), b2, voffB); PG8_STAGE(PG8_SB(0, 1), b2 + hstepB, voffB); PG8_STAGE(PG8_SA(0, 0), a2, voffA);
            PG8_WAIT_V(8); PG8_WAIT_L(0); PG8_BAR; PG8_MMA(1, 0, At, B0); PG8_MMA(1, 1, At, B1); PG8_BAR; PG8_SCHED;
            PG8_LDB(B0, 1, 0); PG8_LDB(B1, 1, 1); PG8_SCHED; PG8_LDA(At, 1, 0); PG8_STAGE(PG8_SA(0, 1), a2 + hstepA, voffA);
            PG8_WAIT_V(8); PG8_WAIT_L(0); PG8_BAR; PG8_MMA(0, 0, At, B0); PG8_MMA(0, 1, At, B1); PG8_BAR; PG8_SCHED;
            PG8_LDA(At, 1, 1); PG8_STAGE(PG8_SB(1, 0), b3, voffB); PG8_STAGE(PG8_SB(1, 1), b3 + hstepB, voffB); PG8_STAGE(PG8_SA(1, 0), a3, voffA);
            PG8_WAIT_V(8); PG8_WAIT_L(0); PG8_BAR; PG8_MMA(1, 0, At, B0); PG8_MMA(1, 1, At, B1); PG8_BAR; PG8_SCHED;
        }
        if constexpr (ALIGN_EPI) { if (wr == 0) PG8_BAR; }
        if constexpr (!Epi::AFTER_DRAIN) { E(acc, cur, wr, wc, fr, fq); }
        if (!has_next) break;
#pragma unroll
        for (int a = 0; a < 2; ++a)
#pragma unroll
            for (int b = 0; b < 2; ++b)
#pragma unroll
                for (int m = 0; m < 4; ++m)
#pragma unroll
                    for (int n = 0; n < 2; ++n) acc[a][b][m][n] = (f32x4){0.f, 0.f, 0.f, 0.f};
        cur = nxt; cA = nA; cB = nB; ++ui;
        if constexpr (ALIGN_EPI) { if (wr == 1) PG8_BAR; }
    }
    PG8_WAIT_V(0);
    if constexpr (!ALIGN_EPI) { if (wr == 0) PG8_BAR; }
    PG8_BAR;
    if constexpr (Epi::AFTER_DRAIN) { E.fused(acc, cur, wr, wc, fr, fq, lds, wid, lane); }
#undef PG8_SA
#undef PG8_SB
#undef PG8_STAGE
#undef PG8_LDA
#undef PG8_LDB
#undef PG8_MMA
#undef PG8_WAIT_V
#undef PG8_WAIT_L
#undef PG8_BAR
#undef PG8_SCHED
}

typedef f32x4 Acc[2][2][4][2];

struct EpiSwiglu {
    static constexpr bool AFTER_DRAIN = false;
    bf16_t* O; bool scaled; RowScale R;
    __device__ __forceinline__ void operator()(const Acc& acc, const Unit& u, int wr, int wc, int fr, int fq) const {
        const int row0 = u.pm * BM + wr * 64 + fr, col0 = u.pn * 128 + wc * 32 + 8 * fq;
#pragma unroll
        for (int ai = 0; ai < 2; ++ai)
#pragma unroll
            for (int m = 0; m < 4; ++m) { const int row = row0 + ai * HALF + m * 16; const float rs = scaled ? row_rs(R, u.pm, ai * HALF + wr * 64 + m * 16 + fr) : 1.0f;
                const f32x4 g0 = acc[ai][0][m][0] * rs, g1 = acc[ai][0][m][1] * rs, u0 = acc[ai][1][m][0] * rs, u1 = acc[ai][1][m][1] * rs;
                u32x4 w; w.x = cvt_pk_bf16(silu_f(g0[0]) * u0[0], silu_f(g0[1]) * u0[1]); w.y = cvt_pk_bf16(silu_f(g0[2]) * u0[2], silu_f(g0[3]) * u0[3]);
                w.z = cvt_pk_bf16(silu_f(g1[0]) * u1[0], silu_f(g1[1]) * u1[1]); w.w = cvt_pk_bf16(silu_f(g1[2]) * u1[2], silu_f(g1[3]) * u1[3]);
                *(u32x4*)(O + ((size_t)(col0 >> 6) * T + row) * 64 + (col0 & 63)) = w; }
    }
};
struct EpiResid {
    static constexpr bool AFTER_DRAIN = false;
    bf16_t* xs; const float* gprev; const float* rsprev; const float* gain; float* ss; float alpha;
    __device__ __forceinline__ void operator()(const Acc& acc, const Unit& u, int wr, int wc, int fr, int fq) const {
        const int row0 = u.pm * BM + wr * 64 + fr, col0 = u.pn * BM + wc * 32 + 8 * fq;
        f32x4 gv[2][2], gi[2][2];
#pragma unroll
        for (int bj = 0; bj < 2; ++bj)
#pragma unroll
            for (int n = 0; n < 2; ++n) { gv[bj][n] = *(const f32x4*)(gain + col0 + bj * HALF + 4 * n); const f32x4 gp = *(const f32x4*)(gprev + col0 + bj * HALF + 4 * n);
                gi[bj][n] = (f32x4){1.0f / gp[0], 1.0f / gp[1], 1.0f / gp[2], 1.0f / gp[3]}; }
#pragma unroll
        for (int ai = 0; ai < 2; ++ai) {
            u32x4 pv[4][2]; float rinv[4];
#pragma unroll
            for (int m = 0; m < 4; ++m) { const int row = row0 + ai * HALF + m * 16; rinv[m] = rsprev ? rsprev[row] : 1.0f;
#pragma unroll
                for (int bj = 0; bj < 2; ++bj) { const int cx = col0 + bj * HALF; pv[m][bj] = *(const u32x4*)(xs + ((size_t)(cx >> 6) * T + row) * 64 + (cx & 63)); } }
#pragma unroll
            for (int m = 0; m < 4; ++m) { const int row = row0 + ai * HALF + m * 16; const float ri = rsprev ? 1.0f / rinv[m] : 1.0f; float s = 0.f;
#pragma unroll
                for (int bj = 0; bj < 2; ++bj) { const int cx = col0 + bj * HALF; bf16_t* px = xs + ((size_t)(cx >> 6) * T + row) * 64 + (cx & 63); const u32x4 pw = pv[m][bj];
                    const f32x4 x0 = (f32x4){bf_lo(pw.x), bf_hi(pw.x), bf_lo(pw.y), bf_hi(pw.y)} * gi[bj][0] * ri, x1 = (f32x4){bf_lo(pw.z), bf_hi(pw.z), bf_lo(pw.w), bf_hi(pw.w)} * gi[bj][1] * ri;
                    const f32x4 y0 = x0 + acc[ai][bj][m][0] * alpha, y1 = x1 + acc[ai][bj][m][1] * alpha;
                    s += (y0[0] * y0[0] + y0[1] * y0[1]) + (y0[2] * y0[2] + y0[3] * y0[3]) + (y1[0] * y1[0] + y1[1] * y1[1]) + (y1[2] * y1[2] + y1[3] * y1[3]);
                    const f32x4 a = y0 * gv[bj][0], b = y1 * gv[bj][1]; u32x4 w; w.x = cvt_pk_bf16(a[0], a[1]); w.y = cvt_pk_bf16(a[2], a[3]); w.z = cvt_pk_bf16(b[0], b[1]); w.w = cvt_pk_bf16(b[2], b[3]);
                    *(u32x4*)px = w; }
                s += __shfl_xor(s, 16); s += __shfl_xor(s, 32);
                if (fq == 0) ss[(size_t)row * 32 + u.pn * 4 + wc] = s; }
            asm volatile("" ::: "memory"); }
    }
};
__device__ __forceinline__ void store_nat(const Acc& acc, bf16_t* base, size_t ldc, int row0, int col0, const float* ss, const RowScale* R = nullptr, int pm = 0) {
#pragma unroll
    for (int ai = 0; ai < 2; ++ai)
#pragma unroll
        for (int m = 0; m < 4; ++m) { const int row = row0 + ai * HALF + m * 16; const float rs = R ? row_rs(*R, pm, row - pm * 256) : (ss ? rstd_of(ss, row) : 1.0f);
#pragma unroll
            for (int bj = 0; bj < 2; ++bj) { const f32x4 a = acc[ai][bj][m][0] * rs, b = acc[ai][bj][m][1] * rs; u32x4 w; w.x = cvt_pk_bf16(a[0], a[1]); w.y = cvt_pk_bf16(a[2], a[3]); w.z = cvt_pk_bf16(b[0], b[1]); w.w = cvt_pk_bf16(b[2], b[3]);
                *(u32x4*)(base + (size_t)row * ldc + col0 + bj * HALF) = w; } }
}
struct EpiWin {
    static constexpr bool AFTER_DRAIN = false;
    bf16_t* P; bf16_t* KT; bf16_t* VT; RowScale R;
    __device__ __forceinline__ void operator()(const Acc& acc, const Unit& u, int wr, int wc, int fr, int fq) const {
        const int row0 = u.pm * BM + wr * 64 + fr;
        if (u.pn < 6 || u.pn >= 12) { store_nat(acc, P, 4096, row0, u.pn * BM + wc * 32 + 8 * fq, nullptr, &R, u.pm); return; }
        const bool isk = u.pn < 8;
#pragma unroll
        for (int ai = 0; ai < 2; ++ai) { const int chunk = u.pm * 4 + ai * 2 + wr;
#pragma unroll
            for (int m = 0; m < 4; ++m) { const float rs = row_rs(R, u.pm, ai * HALF + wr * 64 + m * 16 + fr); const int i = m * 16 + fr;
#pragma unroll
                for (int bj = 0; bj < 2; ++bj)
#pragma unroll
                    for (int n = 0; n < 2; ++n) { const f32x4 a = acc[ai][bj][m][n] * rs; const int c = bj * HALF + wc * 32 + 8 * fq + 4 * n;
                        const unsigned p0 = cvt_pk_bf16(a[0], a[1]), p1 = cvt_pk_bf16(a[2], a[3]);
                        const int t4 = fr & 3; const bool odd = (t4 & 1) != 0, hi2 = (t4 & 2) != 0;
                        const unsigned own1 = odd ? p1 : p0, rcv1 = dpp_quad<0xB1>(odd ? p0 : p1);
                        const unsigned first = odd ? rcv1 : own1, second = odd ? own1 : rcv1;
                        const unsigned qa = (first & 0xffffu) | (second << 16), qb = (first >> 16) | (second & 0xffff0000u);
                        const unsigned own2 = hi2 ? qb : qa, rcv2 = dpp_quad<0x4E>(hi2 ? qa : qb);
                        u32x2 w; w.x = hi2 ? rcv2 : own2; w.y = hi2 ? own2 : rcv2;
                        const int cf = c + (((t4 & 1) << 1) | (t4 >> 1)), i4 = i & ~3;
                        bf16_t* dst;
                        if (isk) { const int kf = (u.pn - 6) * 256 + cf; dst = KT + ((size_t)(chunk * 4 + (kf >> 7)) * 8192 + (size_t)(kf & 127) * 64 + i4); }
                        else { dst = VT + ((size_t)(chunk * 4 + (u.pn - 8)) * 16384 + (size_t)cf * 64 + i4); }
                        *(u32x2*)dst = w; } } }
    }
};
struct EpiMemKV {
    static constexpr bool AFTER_DRAIN = false;
    bf16_t* MK; bf16_t* MV;
    __device__ __forceinline__ void operator()(const Acc& acc, const Unit& u, int wr, int wc, int fr, int fq) const {
        const int h = (u.pn & 7) >> 1, d0 = (u.pn & 1) * 256; bf16_t* base = (u.pn < 8 ? MK : MV) + (size_t)(u.pm * 4 + h) * 256 * 512;
        store_nat(acc, base, 512, wr * 64 + fr, d0 + wc * 32 + 8 * fq, nullptr);
    }
};
struct EpiTile {
    static constexpr bool AFTER_DRAIN = false;
    bf16_t* O; size_t NR;
    __device__ __forceinline__ void operator()(const Acc& acc, const Unit& u, int wr, int wc, int fr, int fq) const {
        bf16_t* base = O + u.o;
#pragma unroll
        for (int ai = 0; ai < 2; ++ai)
#pragma unroll
            for (int m = 0; m < 4; ++m) { const int row = u.r0 + ai * HALF + wr * 64 + m * 16 + fr;
#pragma unroll
                for (int bj = 0; bj < 2; ++bj) { const int col = u.c0 + bj * HALF + wc * 32 + 8 * fq; const f32x4 a = acc[ai][bj][m][0], b = acc[ai][bj][m][1];
                    u32x4 w; w.x = cvt_pk_bf16(a[0], a[1]); w.y = cvt_pk_bf16(a[2], a[3]); w.z = cvt_pk_bf16(b[0], b[1]); w.w = cvt_pk_bf16(b[2], b[3]);
                    *(u32x4*)(base + ((size_t)(col >> 6) * NR + row) * 64 + (col & 63)) = w; } }
    }
};
struct EpiSoftmax {
    static constexpr bool AFTER_DRAIN = true;
    bf16_t* Pout; RowScale R;
    __device__ __forceinline__ void operator()(const Acc&, const Unit&, int, int, int, int) const {}
    __device__ __forceinline__ void fused(Acc& acc, const Unit& u, int wr, int wc, int fr, int fq, LAS unsigned char* lds, int wid, int lane) const {
        LAS float* X = (LAS float*)lds; LAS float* Y = (LAS float*)(lds + 4096);
        const float sc = 0.04419417382f * 1.44269504f;
#pragma unroll
        for (int ai = 0; ai < 2; ++ai)
#pragma unroll
            for (int m = 0; m < 4; ++m) { float mx = -3.0e38f; const float rs = row_rs(R, u.pm, ai * HALF + wr * 64 + m * 16 + fr);
#pragma unroll
                for (int bj = 0; bj < 2; ++bj)
#pragma unroll
                    for (int n = 0; n < 2; ++n) { const f32x4 a = acc[ai][bj][m][n] * rs; acc[ai][bj][m][n] = a; mx = fmaxf(mx, fmaxf(fmaxf(a[0], a[1]), fmaxf(a[2], a[3]))); }
                mx = fmaxf(mx, __shfl_xor(mx, 16)); mx = fmaxf(mx, __shfl_xor(mx, 32));
                if (fq == 0) X[(ai * HALF + wr * 64 + m * 16 + fr) * 4 + wc] = mx; }
        asm volatile("s_waitcnt lgkmcnt(0)" ::: "memory"); __builtin_amdgcn_s_barrier(); asm volatile("" ::: "memory");
#pragma unroll
        for (int ai = 0; ai < 2; ++ai)
#pragma unroll
            for (int m = 0; m < 4; ++m) { const int r = ai * HALF + wr * 64 + m * 16 + fr; const f32x4 mv = *(const LAS f32x4*)(X + r * 4);
                const float rm = fmaxf(fmaxf(mv[0], mv[1]), fmaxf(mv[2], mv[3])) * sc; float s = 0.f;
#pragma unroll
                for (int bj = 0; bj < 2; ++bj)
#pragma unroll
                    for (int n = 0; n < 2; ++n) { f32x4 a = acc[ai][bj][m][n];
#pragma unroll
                        for (int j = 0; j < 4; ++j) { a[j] = __builtin_amdgcn_exp2f(a[j] * sc - rm); s += a[j]; }
                        acc[ai][bj][m][n] = a; }
                s += __shfl_xor(s, 16); s += __shfl_xor(s, 32);
                if (fq == 0) Y[r * 4 + wc] = s; }
        asm volatile("s_waitcnt lgkmcnt(0)" ::: "memory"); __builtin_amdgcn_s_barrier(); asm volatile("" ::: "memory");
        const int row0 = u.pm * BM + wr * 64 + fr, col0 = u.z * 256 + wc * 32 + 8 * fq;
#pragma unroll
        for (int ai = 0; ai < 2; ++ai)
#pragma unroll
            for (int m = 0; m < 4; ++m) { const int r = ai * HALF + wr * 64 + m * 16 + fr; const f32x4 sv = *(const LAS f32x4*)(Y + r * 4);
                const float inv = 1.0f / ((sv[0] + sv[1]) + (sv[2] + sv[3])); const int row = row0 + ai * HALF + m * 16;
#pragma unroll
                for (int bj = 0; bj < 2; ++bj) { const f32x4 a = acc[ai][bj][m][0] * inv, b = acc[ai][bj][m][1] * inv; u32x4 w; w.x = cvt_pk_bf16(a[0], a[1]); w.y = cvt_pk_bf16(a[2], a[3]); w.z = cvt_pk_bf16(b[0], b[1]); w.w = cvt_pk_bf16(b[2], b[3]);
                    const int cp = col0 + bj * HALF; *(u32x4*)(Pout + ((size_t)(cp >> 6) * T + row) * 64 + (cp & 63)) = w; } }
    }
};
struct WinFoldOrder {
    int c; const char* PW; const char* WINU;
    __device__ bool next(int i, Unit& u) const { if (i > 0 || c < 0 || c >= 32) return false; const int g = c >> 3; u.pm = g; u.z = 0; u.pn = c & 7;
        u.a = PW + (size_t)g * 65536 * 2; u.b = WINU + ((size_t)u.pn * 256 * 1024 + g * 256) * 2; u.o = 0; u.r0 = g * 256; u.c0 = u.pn * 256; return true; }
};
struct WqKOrder {
    int c; const char* MK; const char* WQN;
    __device__ bool next(int i, Unit& u) const { if (i > 0 || c < 0 || c >= 64) return false; const int b = c >> 5, h = (c >> 3) & 3; u.pm = b; u.z = h; u.pn = c & 7;
        u.a = MK + (size_t)((b * 4 + h) * 256 * 512) * 2; u.b = WQN + ((size_t)u.pn * 256 * D + h * 512) * 2; u.o = (size_t)b * 1024 * D; u.r0 = h * 256; u.c0 = u.pn * 256; return true; }
};
struct VWoOrder {
    int c; const char* WOT; const char* MV;
    __device__ bool next(int i, Unit& u) const { if (i > 0 || c < 0 || c >= 64) return false; const int b = c >> 5, h = (c >> 3) & 3; u.pm = c & 7; u.z = h; u.pn = 0;
        u.a = WOT + ((size_t)u.pm * 256 * D + h * 512) * 2; u.b = MV + (size_t)((b * 4 + h) * 256 * 512) * 2; u.o = (size_t)b * D * 1024; u.r0 = u.pm * 256; u.c0 = h * 256; return true; }
};
struct LogitOrder {
    int c; const char* A; const char* WQK;
    __device__ bool next(int i, Unit& u) const { if (i > 0 || c >= 256) return false; const int v = (c & 7) * 32 + (c >> 3); u.pm = v >> 2; u.z = v & 3; u.pn = 0; u.o = 0;
        u.a = A + (size_t)u.pm * 256 * 64 * 2; u.b = WQK + ((size_t)(u.pm >> 5) * 1024 * D + (size_t)u.z * 256 * 64) * 2; return true; }
};
struct MemKVOrder {
    int c; const char* A; const char* B;
    __device__ bool next(int i, Unit& u) const { if (i > 0 || c >= 32 || c < 0) return false; u.pm = c & 1; u.pn = c >> 1; u.z = 0; u.o = 0; u.a = A + (size_t)u.pm * 256 * D * 2; u.b = B + (size_t)u.pn * 256 * D * 2; return true; }
};
}

struct Params {
    const float *x, *mem, *ffn1_norm, *ffn1_wg, *ffn1_wu, *ffn1_wd, *mix_norm, *w_in, *pool_w, *pool_scale, *gla_w_a2, *gla_b_a, *gla_head_norm, *w_out,
        *xattn_norm, *mem_norm, *wq, *wkv, *wo, *ffn2_norm, *ffn2_wg, *ffn2_wu, *ffn2_wd, *final_norm;
    float* out; unsigned char* ws;
};

__device__ __forceinline__ float wave_sum(float v) {
#pragma unroll
    for (int o = 1; o < 64; o <<= 1) v += __shfl_xor(v, o);
    return v;
}

__device__ __forceinline__ void conv_item(const float* W, int K, int ld, int nblk, bf16_t* WT, int mode, LAS float* scr, int item, int lane, int tiledNR = 0) {
    const int kb = item / nblk, nb = item - kb * nblk, k0 = 64 * kb, n0 = 64 * nb;
    const float* src = W + (size_t)k0 * ld + n0 + lane;
    float tv[64];
#pragma unroll
    for (int kk = 0; kk < 64; ++kk) tv[kk] = __builtin_nontemporal_load(src + (size_t)kk * ld);
#pragma unroll
    for (int kk = 0; kk < 64; ++kk) scr[kk * 65 + lane] = tv[kk];
    asm volatile("s_waitcnt lgkmcnt(0)" ::: "memory");
    const int c = lane & 7;
    const int rbase = (mode == 0) ? n0 : ((n0 >> 7) * 256 + (n0 & 127) + (mode == 2 ? 128 : 0));
#pragma unroll
    for (int j = 0; j < 8; ++j) { const int n = (lane >> 3) + 8 * j; const LAS float* s = scr + (8 * c) * 65 + n;
        u32x4 o; o.x = cvt_pk_bf16(s[0], s[65]); o.y = cvt_pk_bf16(s[2 * 65], s[3 * 65]); o.z = cvt_pk_bf16(s[4 * 65], s[5 * 65]); o.w = cvt_pk_bf16(s[6 * 65], s[7 * 65]);
        if (tiledNR) *(u32x4*)(WT + ((size_t)(k0 >> 6) * tiledNR + rbase + n) * 64 + 8 * c) = o; else *(u32x4*)(WT + (size_t)(rbase + n) * K + k0 + 8 * c) = o; }
    asm volatile("s_waitcnt lgkmcnt(0)" ::: "memory");
}
template <bool TILED>
__device__ __forceinline__ void rms_row_to_bf16(const float* xrow, const float* gain, bf16_t* obase, int m, int lane, float* rsout = nullptr) {
    f32x4 v[8]; float s = 0.f;
#pragma unroll
    for (int j = 0; j < 8; ++j) { v[j] = *(const f32x4*)(xrow + 4 * lane + 256 * j); s += (v[j][0] * v[j][0] + v[j][1] * v[j][1]) + (v[j][2] * v[j][2] + v[j][3] * v[j][3]); }
    const float rs = rsqrtf(wave_sum(s) * (1.0f / 2048.0f) + EPS);
    if (rsout && lane == 0) rsout[m] = rs;
#pragma unroll
    for (int j = 0; j < 8; ++j) { const f32x4 g = *(const f32x4*)(gain + 4 * lane + 256 * j); const f32x4 y = v[j] * g * rs; u32x2 w; w.x = cvt_pk_bf16(y[0], y[1]); w.y = cvt_pk_bf16(y[2], y[3]);
        const int c = 4 * lane + 256 * j;
        if (TILED) *(u32x2*)(obase + ((size_t)(c >> 6) * T + m) * 64 + (c & 63)) = w; else *(u32x2*)(obase + (size_t)m * D + c) = w; }
}

template <int W>
__device__ __forceinline__ void pool_elem(const bf16_t* PN, const float* pscale, bf16_t* MIX, int tA, int tB, bool hasB, int c) {
    const int tt[2] = {tA, hasB ? tB : tA};
    u32x4 cj[2][W]; int cnt[2];
#pragma unroll
    for (int q = 0; q < 2; ++q) { const int spos = tt[q] & (SEQ - 1); cnt[q] = (spos + 1 < W) ? spos + 1 : W; const char* up = (const char*)(PN + (size_t)tt[q] * 4096 + c);
#pragma unroll
        for (int j = 0; j < W; ++j) { const unsigned jj = (j < cnt[q]) ? (unsigned)j : 0u; cj[q][j] = *(const u32x4*)(up - jj * 8192u); } }
    const f32x4 p0 = *(const f32x4*)(pscale + c), p1 = *(const f32x4*)(pscale + c + 4);
#pragma unroll
    for (int q = 0; q < 2; ++q) { const float inv = 1.0f / (float)cnt[q];
        float s[8] = {0.f, 0.f, 0.f, 0.f, 0.f, 0.f, 0.f, 0.f};
#pragma unroll
        for (int j = 0; j < W; ++j) { const float m = (j < cnt[q]) ? 1.0f : 0.0f; const u32x4 v = cj[q][j];
            s[0] += m * bf_lo(v.x); s[1] += m * bf_hi(v.x); s[2] += m * bf_lo(v.y); s[3] += m * bf_hi(v.y);
            s[4] += m * bf_lo(v.z); s[5] += m * bf_hi(v.z); s[6] += m * bf_lo(v.w); s[7] += m * bf_hi(v.w); }
        const u32x4 z0 = cj[q][0];
        u32x4 w; w.x = cvt_pk_bf16((s[0] * inv - bf_lo(z0.x)) * p0[0], (s[1] * inv - bf_hi(z0.x)) * p0[1]); w.y = cvt_pk_bf16((s[2] * inv - bf_lo(z0.y)) * p0[2], (s[3] * inv - bf_hi(z0.y)) * p0[3]);
        w.z = cvt_pk_bf16((s[4] * inv - bf_lo(z0.z)) * p1[0], (s[5] * inv - bf_hi(z0.z)) * p1[1]); w.w = cvt_pk_bf16((s[6] * inv - bf_lo(z0.w)) * p1[2], (s[7] * inv - bf_hi(z0.w)) * p1[3]);
        if (q == 0 || hasB) *(u32x4*)(MIX + ((size_t)(c >> 6) * T + tt[q]) * 64 + (c & 63)) = w; }
}

#define XB_TMO      128
#define XB_XCNT(j)  (256  + 64 * (j))
#define XB_XSUB(j)  (1280 + 64 * (j))
#define XB_XGEN(j)  (2304 + 64 * (j))
#define XB_TOP      3328
#define XB_TOPGEN   3392
#define XCD_BAR_WORDS 3456
#define XB_SPIN_CAP (1u << 18)

__device__ __forceinline__ unsigned xb_ld(unsigned* p)              { return __hip_atomic_load(p, __ATOMIC_RELAXED, __HIP_MEMORY_SCOPE_AGENT); }
__device__ __forceinline__ unsigned xb_add(unsigned* p, unsigned v) { return __hip_atomic_fetch_add(p, v, __ATOMIC_RELAXED, __HIP_MEMORY_SCOPE_AGENT); }
__device__ __forceinline__ unsigned xb_xcc_id() { return (unsigned)__builtin_amdgcn_s_getreg((3 << 11) | 20) & 0xFu; }
#define XB_SPIN(cond, bar) do { unsigned _sp = 0; while (cond) { __builtin_amdgcn_s_sleep(1); \
    if ((++_sp & 255u) == 0u) { if (xb_ld(&(bar)[XB_TMO])) break; if (_sp > XB_SPIN_CAP) { atomicAdd(&(bar)[XB_TMO], 1u); break; } } } } while (0)

struct XcdBarrier {
    unsigned* bar; unsigned x;
    volatile LAS unsigned* st;
};

__device__ __forceinline__ XcdBarrier xcd_barrier_post(unsigned* bar, volatile LAS unsigned* st) {
    XcdBarrier b; b.bar = bar; b.x = xb_xcc_id(); b.st = st;
    if (threadIdx.x == 0) (void)xb_add(&bar[XB_XCNT(b.x)], 1u);
    return b;
}
__device__ __forceinline__ void xcd_barrier_complete(unsigned* bar, unsigned x, unsigned& nloc, unsigned& nx) {
    const unsigned G = gridDim.x * gridDim.y * gridDim.z;
    unsigned sum, cnt, mine, sp = 0u;
    for (;;) {
        sum = 0u; cnt = 0u; mine = 0u;
#pragma unroll
        for (unsigned j = 0; j < 16; ++j) { const unsigned c = xb_ld(&bar[XB_XCNT(j)]); sum += c; cnt += (c > 0u) ? 1u : 0u; mine = (j == x) ? c : mine; }
        if (sum == G) break;
        __builtin_amdgcn_s_sleep(1);
        if ((++sp & 255u) == 0u) { if (xb_ld(&bar[XB_TMO])) break; if (sp > XB_SPIN_CAP) { atomicAdd(&bar[XB_TMO], 1u); break; } }
    }
    nloc = mine > 0u ? mine : 1u; nx = cnt > 0u ? cnt : 1u;
}

__device__ __forceinline__ void xcd_barrier(const XcdBarrier& b) {
    asm volatile("s_waitcnt vmcnt(0)" ::: "memory");
    __syncthreads();
    if (threadIdx.x == 0) {
        unsigned* bar = b.bar;
        __builtin_amdgcn_s_waitcnt(0);
        unsigned nloc = b.st[0], nx = b.st[1];
        if (nloc == 0u) { xcd_barrier_complete(bar, b.x, nloc, nx); b.st[0] = nloc; b.st[1] = nx; }
        const unsigned old = xb_add(&bar[XB_XSUB(b.x)], 1u);
        const unsigned gen = old / nloc;
        if (old + 1u == (gen + 1u) * nloc) {
            __builtin_amdgcn_fence(__ATOMIC_RELEASE, "agent");
            asm volatile("s_waitcnt vmcnt(0)" ::: "memory");
            const unsigned og = xb_add(&bar[XB_TOP], 1u);
            const unsigned tg = og / nx;
            if (og + 1u == (tg + 1u) * nx) xb_add(&bar[XB_TOPGEN], 1u);
            else XB_SPIN(xb_ld(&bar[XB_TOPGEN]) == tg, bar);
            __builtin_amdgcn_fence(__ATOMIC_ACQUIRE, "agent");
            xb_add(&bar[XB_XGEN(b.x)], 1u);
            asm volatile("s_waitcnt vmcnt(0)" ::: "memory");
        } else {
            XB_SPIN(xb_ld(&bar[XB_XGEN(b.x)]) == gen, bar);
            __builtin_amdgcn_fence(__ATOMIC_ACQUIRE, "agent");
            asm volatile("s_waitcnt vmcnt(0)" ::: "memory");
        }
    }
    __syncthreads();
}

#define GRID_SYNC() xcd_barrier(xbar)
__global__ void __launch_bounds__(NTHR, 2) fwd_megakernel(Params p) {
    extern __shared__ __attribute__((aligned(16))) unsigned char lds_raw[];
    LAS unsigned char* lds = (LAS unsigned char*)lds_raw;
    cg::grid_group grid = cg::this_grid();
    const int tid = threadIdx.x, lane = tid & 63, wave = __builtin_amdgcn_readfirstlane(tid >> 6), fr = lane & 15, fq = lane >> 4;
    const int bx = blockIdx.x, G = gridDim.x;
    const int gw = bx * 8 + wave, NGW = G * 8;
    const size_t gtid = (size_t)bx * NTHR + tid, NGT = (size_t)G * NTHR;
    unsigned char* ws = p.ws;
    volatile LAS unsigned* xst = (volatile LAS unsigned*)(lds + 133120);
    if (tid < 2) xst[tid] = 0u;
    __syncthreads();
    XcdBarrier xbar = xcd_barrier_post((unsigned*)(ws + WS_BAR), xst);
    if (p.ws == nullptr) grid.sync();
    float* SS = (float*)(ws + WS_SS); float* ALR = (float*)(ws + WS_ALR); float* BEND = (float*)(ws + WS_BEND);
    bf16_t* MEMH = (bf16_t*)(ws + WS_MEMH); bf16_t* MEMK = (bf16_t*)(ws + WS_MEMK); bf16_t* MEMVT = (bf16_t*)(ws + WS_MEMVT);
    bf16_t* W1GU = (bf16_t*)(ws + WS_W1GU); bf16_t* W1D = (bf16_t*)(ws + WS_W1D); bf16_t* W2GU = (bf16_t*)(ws + WS_W2GU); bf16_t* W2D = (bf16_t*)(ws + WS_W2D);
    bf16_t* WIN = (bf16_t*)(ws + WS_WIN); bf16_t* WA = (bf16_t*)(ws + WS_WA); bf16_t* POOLW = (bf16_t*)(ws + WS_POOLW); bf16_t* WOUT = (bf16_t*)(ws + WS_WOUT);
    bf16_t* WQ = (bf16_t*)(ws + WS_WQ); bf16_t* WKV = (bf16_t*)(ws + WS_WKV); bf16_t* WO = (bf16_t*)(ws + WS_WO);
    bf16_t* H = (bf16_t*)(ws + WS_H); bf16_t* ACT = (bf16_t*)(ws + WS_ACT); bf16_t* MIX = (bf16_t*)(ws + WS_MIX);
    bf16_t* PN = ACT; bf16_t* KT = (bf16_t*)(ws + WS_ACT + ACT_KT); bf16_t* VT = (bf16_t*)(ws + WS_ACT + ACT_VT);
    bf16_t* PATT = (bf16_t*)(ws + WS_ACT + ACT_PATT); bf16_t* WQK = (bf16_t*)(ws + WS_ACT + ACT_WQK); bf16_t* VWOT = (bf16_t*)(ws + WS_ACT + ACT_VWOT);
    bf16_t* KV = (bf16_t*)p.out;
    float* RS0 = (float*)(ws + WS_RS0);
    LAS float* RSL = (LAS float*)(lds + 135168);

    {
        LAS float* scr = (LAS float*)(lds + wave * 16640);
        constexpr int I_FF = (D / 64) * (FF / 64);
        constexpr int I_IN = (D / 64) * (4096 / 64);
        constexpr int I_DD = (D / 64) * (D / 64);
        constexpr int I_INR = (D / 64) * (3072 / 64);
        constexpr int NITEMS = 6 * I_FF + I_INR + 64 + I_DD * 2 + I_IN;
        for (int it = gw; it < NITEMS; it += NGW) {
            int r = it;
            if (r < I_FF) { conv_item(p.ffn1_wg, D, FF, FF / 64, W1GU, 1, scr, r, lane, 2 * FF); continue; } r -= I_FF;
            if (r < I_FF) { conv_item(p.ffn1_wu, D, FF, FF / 64, W1GU, 2, scr, r, lane, 2 * FF); continue; } r -= I_FF;
            if (r < I_FF) { conv_item(p.ffn1_wd, FF, D, D / 64, W1D, 0, scr, r, lane, D); continue; } r -= I_FF;
            if (r < I_FF) { conv_item(p.ffn2_wg, D, FF, FF / 64, W2GU, 1, scr, r, lane, 2 * FF); continue; } r -= I_FF;
            if (r < I_FF) { conv_item(p.ffn2_wu, D, FF, FF / 64, W2GU, 2, scr, r, lane, 2 * FF); continue; } r -= I_FF;
            if (r < I_FF) { conv_item(p.ffn2_wd, FF, D, D / 64, W2D, 0, scr, r, lane, D); continue; } r -= I_FF;
            if (r < I_INR) { conv_item(p.w_in + 1024, D, 4112, 3072 / 64, WIN + (size_t)1024 * 64, 0, scr, r, lane, 4096); continue; } r -= I_INR;
            if (r < 64) { const int g = r >> 4; conv_item(p.pool_w + (size_t)g * 65536, 256, 256, 4, POOLW + (size_t)g * 65536, 0, scr, r & 15, lane); continue; } r -= 64;
            if (r < I_DD) { conv_item(p.w_out, D, D, D / 64, WOUT, 0, scr, r, lane, D); continue; } r -= I_DD;
            if (r < I_DD) { conv_item(p.wo, D, D, D / 64, WO, 0, scr, r, lane); continue; } r -= I_DD;
            conv_item(p.wkv, D, 4096, 4096 / 64, WKV, 0, scr, r, lane);
        }
        for (size_t i = gtid; i < (size_t)D * D / 8; i += NGT) { const f32x4 a = ((const f32x4*)p.wq)[2 * i], b = ((const f32x4*)p.wq)[2 * i + 1];
            u32x4 w; w.x = cvt_pk_bf16(a[0], a[1]); w.y = cvt_pk_bf16(a[2], a[3]); w.z = cvt_pk_bf16(b[0], b[1]); w.w = cvt_pk_bf16(b[2], b[3]); ((u32x4*)WQ)[i] = w; }
        for (size_t i = gtid; i < (size_t)D * 1024 / 8; i += NGT) { const size_t kd = i >> 7, c = (i & 127) * 8; const float* src = p.w_in + kd * 4112 + c;
            const f32x4 a = *(const f32x4*)src, b = *(const f32x4*)(src + 4);
            u32x4 w; w.x = cvt_pk_bf16(a[0], a[1]); w.y = cvt_pk_bf16(a[2], a[3]); w.z = cvt_pk_bf16(b[0], b[1]); w.w = cvt_pk_bf16(b[2], b[3]); ((u32x4*)MIX)[i] = w; }
        for (size_t i = gtid; i < 32768; i += NGT) { const int k = (int)(i >> 4), r = (int)(i & 15); WA[r * D + k] = (bf16_t)cvt_pk_bf16(p.w_in[(size_t)k * 4112 + 4096 + r], 0.f); }
        for (int m = gw; m < T + MEMT; m += NGW) {
            if (m < T) rms_row_to_bf16<true>(p.x + (size_t)m * D, p.ffn1_norm, H, m, lane, RS0);
            else rms_row_to_bf16<false>(p.mem + (size_t)(m - T) * D, p.mem_norm, MEMH, m - T, lane);
        }
    }
    GRID_SYNC();
    { pg8::StdOrder S; S.init(T, 2 * FF, G, bx, H, 64, W1GU, 64); pg8::EpiSwiglu E{ACT, false, RowScale{nullptr, nullptr, -1}}; pg8::gemm_phase<true>(lds, 64, 64, D, S, E, (size_t)T * 64 * 2, (size_t)2 * FF * 64 * 2); }
    GRID_SYNC();
    { pg8::StdOrder S; S.init(T, D, G, bx, ACT, 64, W1D, 64); S.wgm = 4; pg8::EpiResid E{H, p.ffn1_norm, RS0, p.mix_norm, SS, 0.5f}; pg8::gemm_phase<true>(lds, 64, 64, FF, S, E, (size_t)T * 64 * 2, (size_t)D * 64 * 2); }
    { pg8::WinFoldOrder S{bx, (const char*)POOLW, (const char*)MIX}; pg8::EpiTile E{WIN, (size_t)4096}; pg8::gemm_phase<true>(lds, 256, 1024, 256, S, E); }
    GRID_SYNC();
    {
        { pg8::StdOrder S; S.init(T, 4096, G, bx, H, 64, WIN, 64); pg8::Unit u0; u0.pm = -1; (void)S.next(0, u0); if (u0.pm >= 0) fill_rsl(RSL, SS, u0.pm);
          pg8::EpiWin E{PN, KT, VT, RowScale{SS, RSL, u0.pm}}; pg8::gemm_phase<true>(lds, 64, 64, D, S, E, (size_t)T * 64 * 2, (size_t)4096 * 64 * 2); }
        {
            const int tb = wave & 3, kh = wave >> 2; const int tok = bx * 64 + tb * 16 + fr;
            const bf16_t* ap = H + ((size_t)(kh * 16) * T + tok) * 64 + fq * 8; const bf16_t* wp = WA + (size_t)fr * D + kh * 1024 + fq * 8;
            f32x4 acc = {0.f, 0.f, 0.f, 0.f};
#pragma unroll 8
            for (int ks = 0; ks < 32; ++ks) { const bf16x8 wf = *(const bf16x8*)(wp + ks * 32), af = *(const bf16x8*)(ap + (size_t)(ks >> 1) * T * 64 + (ks & 1) * 32); acc = __builtin_amdgcn_mfma_f32_16x16x32_bf16(wf, af, acc, 0, 0, 0); }
            LAS f32x4* ex = (LAS f32x4*)lds;
            if (kh == 1) ex[tb * 64 + lane] = acc;
            __syncthreads();
            if (kh == 0) { const f32x4 o = (acc + ex[tb * 64 + lane]) * rstd_of(SS, tok); *(f32x4*)(ALR + (size_t)tok * 16 + 4 * fq) = o; }
        }
    }
    GRID_SYNC();
    constexpr int GA = 224;
    if (bx >= GA) { pg8::MemKVOrder S{bx - GA, (const char*)MEMH, (const char*)WKV}; pg8::EpiMemKV E{MEMK, MEMVT}; pg8::gemm_phase<true>(lds, D, D, D, S, E); }
    else {
        LAS float* alr_s = (LAS float*)lds; LAS float* w2_s = (LAS float*)(lds + 4096); LAS float* ba_s = (LAS float*)(lds + 12288); LAS float* gsum = (LAS float*)(lds + 12800);
        LAS bf16_t* KD = (LAS bf16_t*)(lds + 16384);
        {
            const int h = bx & 3; const int k = tid & 127, fg = tid >> 7;
            { const int idx = tid * 4, r = idx >> 7, kk = idx & 127; *(LAS f32x4*)(w2_s + idx) = *(const f32x4*)(p.gla_w_a2 + r * 512 + h * 128 + kk); }
            const float bk = p.gla_b_a[h * 128 + k];
            __syncthreads();
            float w[16];
#pragma unroll
            for (int r = 0; r < 16; ++r) w[r] = w2_s[r * 128 + k];
            f32x4 n_alr = {0.f, 0.f, 0.f, 0.f}; u32x4 n_k0, n_k1; bf16x8 n_vf[2][2];
#define GLA_A_PREFETCH(uu) do { if (tid < 256) n_alr = ((const f32x4*)(ALR + (size_t)((uu) >> 2) * 64 * 16))[tid]; \
                { const u32x4* kp_ = (const u32x4*)(KT + (size_t)(uu) * 8192 + (size_t)k * 64 + fg * 16); n_k0 = kp_[0]; n_k1 = kp_[1]; } \
                _Pragma("unroll") for (int vv = 0; vv < 2; ++vv) _Pragma("unroll") for (int ks = 0; ks < 2; ++ks) \
                    n_vf[vv][ks] = *(const bf16x8*)(VT + (size_t)(uu) * 16384 + (size_t)((2 * wave + vv) * 16 + fr) * 64 + ks * 32 + fq * 8); } while (0)
            GLA_A_PREFETCH(bx);
            for (int u = bx; u < 1024; u += GA) {
                const f32x4 c_alr = n_alr; const u32x4 k0 = n_k0, k1 = n_k1; bf16x8 vf[2][2];
#pragma unroll
                for (int vv = 0; vv < 2; ++vv)
#pragma unroll
                    for (int ks = 0; ks < 2; ++ks) vf[vv][ks] = n_vf[vv][ks];
                if (u + GA < 1024) GLA_A_PREFETCH(u + GA);
                if (tid < 256) ((LAS f32x4*)alr_s)[tid] = c_alr;
                __syncthreads();
                float cum[16]; float run = 0.f;
#pragma unroll
                for (int ii = 0; ii < 16; ++ii) { const int i = fg * 16 + ii; float z = bk;
#pragma unroll
                    for (int r = 0; r < 16; ++r) z += alr_s[i * 16 + r] * w[r];
                    const float la = -(fmaxf(-z, 0.f) + __logf(1.0f + __expf(-fabsf(z)))) * (1.0f / 16.0f);
                    run += la; cum[ii] = run; }
                gsum[fg * 128 + k] = run;
                __syncthreads();
                float prefix = 0.f, total = 0.f;
#pragma unroll
                for (int f = 0; f < 4; ++f) { const float gsv = gsum[f * 128 + k]; total += gsv; if (f < fg) prefix += gsv; }
                if (fg == 0) BEND[(size_t)u * 128 + k] = total;
                { const unsigned kw[8] = {k0.x, k0.y, k0.z, k0.w, k1.x, k1.y, k1.z, k1.w}; unsigned ow[8];
#pragma unroll
                  for (int q = 0; q < 8; ++q) { const float d0 = __expf(total - (cum[2 * q] + prefix)), d1 = __expf(total - (cum[2 * q + 1] + prefix)); ow[q] = cvt_pk_bf16(bf_lo(kw[q]) * d0, bf_hi(kw[q]) * d1); }
                  LAS u32x4* dst = (LAS u32x4*)(KD + k * 72 + fg * 16); dst[0] = (u32x4){ow[0], ow[1], ow[2], ow[3]}; dst[1] = (u32x4){ow[4], ow[5], ow[6], ow[7]}; }
                __syncthreads();
#pragma unroll
                for (int kp = 0; kp < 4; ++kp) { u32x2 w0[2], w1[2];
#pragma unroll
                    for (int kq = 0; kq < 2; ++kq) { const int kb = 2 * kp + kq; f32x4 a0 = {0.f, 0.f, 0.f, 0.f}, a1 = {0.f, 0.f, 0.f, 0.f};
#pragma unroll
                        for (int ks = 0; ks < 2; ++ks) { const bf16x8 kf = *(const LAS bf16x8*)(KD + (kb * 16 + fr) * 72 + ks * 32 + fq * 8);
                            a0 = __builtin_amdgcn_mfma_f32_16x16x32_bf16(kf, vf[0][ks], a0, 0, 0, 0); a1 = __builtin_amdgcn_mfma_f32_16x16x32_bf16(kf, vf[1][ks], a1, 0, 0, 0); }
                        w0[kq].x = cvt_pk_bf16(a0[0], a0[1]); w0[kq].y = cvt_pk_bf16(a0[2], a0[3]); w1[kq].x = cvt_pk_bf16(a1[0], a1[1]); w1[kq].y = cvt_pk_bf16(a1[2], a1[3]); }
                    const int eo = kp * 32 + (fq & 1) * 16 + (fq >> 1) * 8;
                    *(u32x4*)(KV + (size_t)u * 32768 + (size_t)((2 * wave) * 16 + fr) * 128 + eo) = pair16(w0[0], w0[1]);
                    *(u32x4*)(KV + (size_t)u * 32768 + (size_t)((2 * wave + 1) * 16 + fr) * 128 + eo) = pair16(w1[0], w1[1]); }
                __syncthreads();
            }
#undef GLA_A_PREFETCH
        }
        { const int gwp = bx * 8 + wave; constexpr int NWP = GA * 8;
          for (int g = 0; g < 4; ++g)
            for (int tp = gwp; tp < 8192; tp += 2 * NWP) { const int tpB = tp + NWP; const bool hasB = tpB < 8192;
                const int tA = 2 * tp + (lane >> 5), tB = 2 * tpB + (lane >> 5), c = g * 256 + (lane & 31) * 8;
                if (g == 0) pool_elem<2>(PN, p.pool_scale, MIX, tA, tB, hasB, c);
                else if (g == 1) pool_elem<4>(PN, p.pool_scale, MIX, tA, tB, hasB, c);
                else if (g == 2) pool_elem<8>(PN, p.pool_scale, MIX, tA, tB, hasB, c);
                else pool_elem<16>(PN, p.pool_scale, MIX, tA, tB, hasB, c); } }
    }
    GRID_SYNC();
    {
        int t5 = threadIdx.x; asm volatile("" : "+v"(t5));
        if (bx < 128) {
            const int e = bx * NTHR + t5; const int bh = e >> 13, qd = e & 8191; const int b = bh >> 2, h = bh & 3; const int k = 4 * (qd & 31);
            LAS float* gex = (LAS float*)lds;
#pragma unroll
            for (int j8 = 0; j8 < 8; ++j8) { const int idx = (j8 * NTHR + t5) * 4, c = idx >> 7, kk = idx & 127; const f32x4 g4 = *(const f32x4*)(BEND + (size_t)((b * 128 + c) * 4 + h) * 128 + kk);
                *(LAS f32x4*)(gex + idx) = (f32x4){__expf(g4[0]), __expf(g4[1]), __expf(g4[2]), __expf(g4[3])}; }
            __syncthreads();
            f32x4 st = {0.f, 0.f, 0.f, 0.f};
            for (int c0 = 0; c0 < 128; c0 += 32) {
                u32x2 kvw[32];
#pragma unroll
                for (int q = 0; q < 32; ++q) { const size_t u = (size_t)((b * 128 + c0 + q) * 4 + h); kvw[q] = *(const u32x2*)(KV + u * 32768 + 4 * qd); }
#pragma unroll
                for (int q = 0; q < 32; ++q) { const size_t u = (size_t)((b * 128 + c0 + q) * 4 + h); const f32x4 ge = *(const LAS f32x4*)(gex + (c0 + q) * 128 + k);
                    st[0] = ge[0] * st[0] + bf_lo(kvw[q].x); st[1] = ge[1] * st[1] + bf_hi(kvw[q].x);
                    st[2] = ge[2] * st[2] + bf_lo(kvw[q].y); st[3] = ge[3] * st[3] + bf_hi(kvw[q].y);
                    u32x2 o; o.x = cvt_pk_bf16(st[0], st[1]); o.y = cvt_pk_bf16(st[2], st[3]);
                    *(u32x2*)(KV + u * 32768 + 4 * qd) = o; }
            }
        }
        { pg8::WqKOrder S{bx - 128, (const char*)MEMK, (const char*)WQ}; pg8::EpiTile E{WQK, (size_t)1024}; pg8::gemm_phase<true>(lds, 512, D, 512, S, E); }
        { pg8::VWoOrder S{bx - 192, (const char*)WO, (const char*)MEMVT}; pg8::EpiTile E{VWOT, (size_t)D}; pg8::gemm_phase<true>(lds, D, 512, 512, S, E); }
    }
    GRID_SYNC();
    {
        LAS float* exch = (LAS float*)lds;
        f32x4 hn[8];
#pragma unroll
        for (int vb = 0; vb < 8; ++vb) hn[vb] = *(const f32x4*)(p.gla_head_norm + (bx & 3) * 256 + (wave >> 2) * 128 + vb * 16 + 4 * fq);
        for (int u = bx; u < 1024; u += G) {
            const int h = u & 3, chunk = u >> 2; const int t0 = chunk * 64; const int tb = wave & 3, vh = wave >> 2; const int t = t0 + tb * 16 + fr;
            u32x2 gt[8];
#pragma unroll
            for (int vb = 0; vb < 8; ++vb) gt[vb] = *(const u32x2*)(PN + (size_t)t * 4096 + 3072 + h * 256 + vh * 128 + vb * 16 + 4 * fq);
            bf16x8 qf[4];
#pragma unroll
            for (int ks = 0; ks < 4; ++ks) qf[ks] = *(const bf16x8*)(PN + (size_t)t * 4096 + 1024 + h * 128 + ks * 32 + fq * 8);
            f32x4 acc[8]; float ssq = 0.f;
#pragma unroll
            for (int vb = 0; vb < 8; ++vb) { f32x4 a = {0.f, 0.f, 0.f, 0.f};
#pragma unroll
                for (int ks = 0; ks < 4; ++ks) { const bf16x8 sf = *(const bf16x8*)(KV + (size_t)u * 32768 + (size_t)((vh * 8 + vb) * 16 + fr) * 128 + ks * 32 + fq * 8); a = __builtin_amdgcn_mfma_f32_16x16x32_bf16(sf, qf[ks], a, 0, 0, 0); }
                a = a * 0.08838834764f; acc[vb] = a; ssq += (a[0] * a[0] + a[1] * a[1]) + (a[2] * a[2] + a[3] * a[3]); }
            ssq += __shfl_xor(ssq, 16); ssq += __shfl_xor(ssq, 32);
            if (fq == 0) exch[(vh * 4 + tb) * 16 + fr] = ssq;
            __syncthreads();
            const float tot = exch[tb * 16 + fr] + exch[(4 + tb) * 16 + fr]; const float rs = rsqrtf(tot * (1.0f / 256.0f) + EPS);
#pragma unroll
            for (int vp = 0; vp < 4; ++vp) { u32x2 w2[2];
#pragma unroll
                for (int vq = 0; vq < 2; ++vq) { const int vb = 2 * vp + vq; const u32x2 gw2 = gt[vb];
                    const f32x4 o = acc[vb] * rs * hn[vb]; w2[vq].x = cvt_pk_bf16(o[0] * silu_f(bf_lo(gw2.x)), o[1] * silu_f(bf_hi(gw2.x))); w2[vq].y = cvt_pk_bf16(o[2] * silu_f(bf_lo(gw2.y)), o[3] * silu_f(bf_hi(gw2.y))); }
                const int cm = 1024 + h * 256 + vh * 128 + vp * 32 + (fq & 1) * 16 + (fq >> 1) * 8;
                *(u32x4*)(MIX + ((size_t)(cm >> 6) * T + t) * 64 + (cm & 63)) = pair16(w2[0], w2[1]); }
            __syncthreads();
        }
    }
    GRID_SYNC();
    { pg8::StdOrder S; S.init(T, D, G, bx, MIX, 64, WOUT, 64); pg8::EpiResid E{H, p.mix_norm, nullptr, p.xattn_norm, SS + 32 * T, 1.0f}; pg8::gemm_phase<true>(lds, 64, 64, D, S, E, (size_t)T * 64 * 2, (size_t)D * 64 * 2); }
    GRID_SYNC();
    { pg8::LogitOrder S{bx, (const char*)H, (const char*)WQK}; pg8::Unit u0; u0.pm = -1; (void)S.next(0, u0); if (u0.pm >= 0) fill_rsl(RSL, SS + 32 * T, u0.pm);
      pg8::EpiSoftmax E{PATT, RowScale{SS + 32 * T, RSL, u0.pm}}; pg8::gemm_phase<false>(lds, 64, 64, D, S, E, (size_t)T * 64 * 2, (size_t)1024 * 64 * 2); }
    GRID_SYNC();
    { pg8::StdOrder S; S.init(T, D, G, bx, PATT, 64, VWOT, 64); S.bbatch = (size_t)D * 1024 * 2; pg8::EpiResid E{H, p.xattn_norm, nullptr, p.ffn2_norm, SS + 64 * T, 1.0f}; pg8::gemm_phase<true>(lds, 64, 64, 1024, S, E, (size_t)T * 64 * 2, (size_t)D * 64 * 2); }
    GRID_SYNC();
    { pg8::StdOrder S; S.init(T, 2 * FF, G, bx, H, 64, W2GU, 64); pg8::Unit u0; u0.pm = -1; (void)S.next(0, u0); if (u0.pm >= 0) fill_rsl(RSL, SS + 64 * T, u0.pm);
      pg8::EpiSwiglu E{ACT, true, RowScale{SS + 64 * T, RSL, u0.pm}}; pg8::gemm_phase<true>(lds, 64, 64, D, S, E, (size_t)T * 64 * 2, (size_t)2 * FF * 64 * 2); }
    GRID_SYNC();
    { pg8::StdOrder S; S.init(T, D, G, bx, ACT, 64, W2D, 64); S.wgm = 4; pg8::EpiResid E{H, p.ffn2_norm, nullptr, p.final_norm, SS + 96 * T, 0.5f};   pg8::gemm_phase<true>(lds, 64, 64, FF, S, E, (size_t)T * 64 * 2, (size_t)D * 64 * 2); }
    GRID_SYNC();
    { int t14 = threadIdx.x; asm volatile("" : "+v"(t14)); const int l14 = t14 & 63, gw14 = blockIdx.x * 8 + (t14 >> 6);
      const float* ss3 = SS + 96 * T;
      for (int m = gw14; m < T; m += NGW) {
          const float part = (l14 < 32) ? ss3[(size_t)m * 32 + l14] : 0.f; const float rs = rsqrtf(wave_sum(part) * (1.0f / 2048.0f) + EPS);
#pragma unroll
          for (int j4 = 0; j4 < 4; ++j4) { const int col = (l14 + 64 * j4) * 8; const u32x4 w = *(const u32x4*)(H + ((size_t)(col >> 6) * T + m) * 64 + (col & 63));
              f32x4 a, b; a[0] = bf_lo(w.x) * rs; a[1] = bf_hi(w.x) * rs; a[2] = bf_lo(w.y) * rs; a[3] = bf_hi(w.y) * rs; b[0] = bf_lo(w.z) * rs; b[1] = bf_hi(w.z) * rs; b[2] = bf_lo(w.w) * rs; b[3] = bf_hi(w.w) * rs;
              *(f32x4*)(p.out + (size_t)m * D + col) = a; *(f32x4*)(p.out + (size_t)m * D + col + 4) = b; } } }
}

extern "C" void kernel_launch(void* const* d_in, const int* in_sizes, int n_in, void* d_out, int out_size, void* d_ws, size_t ws_size, hipStream_t stream) {
    static int grid = 0;
    if (grid == 0) {
        if (n_in != 24 || out_size != T * D || ws_size < WS_END) { fprintf(stderr, "kernel_launch: unexpected shapes n_in %d out %d ws %zu (need %zu)\n", n_in, out_size, ws_size, (size_t)WS_END); grid = -1; return; }
        int dev = 0, cus = 0, per_cu = 0;
        (void)hipGetDevice(&dev); (void)hipDeviceGetAttribute(&cus, hipDeviceAttributeMultiprocessorCount, dev);
        (void)hipFuncSetAttribute((const void*)fwd_megakernel, hipFuncAttributeMaxDynamicSharedMemorySize, LDS_BYTES);
        (void)hipOccupancyMaxActiveBlocksPerMultiprocessor(&per_cu, (const void*)fwd_megakernel, NTHR, LDS_BYTES);
        (void)hipGetLastError();
        grid = cus < NWG ? cus : NWG;
        if (per_cu < 1) fprintf(stderr, "kernel_launch: occupancy query says %d blocks/CU\n", per_cu);
    }
    if (grid < 0) return;
    if (hipMemsetAsync((char*)d_ws + WS_BAR, 0, 16384, stream) != hipSuccess) { fprintf(stderr, "kernel_launch: memset failed\n"); return; }
    Params p{};
    const float** pp = (const float**)&p;
    for (int i = 0; i < 24; ++i) pp[i] = (const float*)d_in[i];
    p.out = (float*)d_out; p.ws = (unsigned char*)d_ws;
    void* args[] = {&p};
    hipError_t e = hipLaunchCooperativeKernel((const void*)fwd_megakernel, dim3(grid), dim3(NTHR), args, LDS_BYTES, stream);
    if (e != hipSuccess) fprintf(stderr, "cooperative launch failed: %s (grid %d)\n", hipGetErrorString(e), grid);
}
```
